# Optimizing an MI355X kernel written in HIP

```python
import math
import jax
import jax.numpy as jnp
from jax import lax
import numpy as np

D_MODEL = 1024
BATCH = 2
SEQ = 8192
DEPTH = 1

CHUNK = 64
LEFT_CHUNKS = 8
BAND = (LEFT_CHUNKS + 1) * CHUNK

HEAD_DIM = 64
N_HEADS_A = 8
N_HEADS_B = 8
WIDTH_A = N_HEADS_A * HEAD_DIM
WIDTH_B = N_HEADS_B * HEAD_DIM
MIX_WIDTH = WIDTH_A + WIDTH_B
REL_CLIP = 128
N_REL = 2 * REL_CLIP + 1
SB_BLOCK = 128

MEM_LEN = 256
N_HEADS_MEM = 4
HEAD_DIM_MEM = D_MODEL // N_HEADS_MEM

N_EXPERTS = 32
TOP_K = 4
D_FF = D_MODEL
SWIGLU_LIMIT = 7.0
SWIGLU_ALPHA = 1.702
MOE_BLOCK = 128

LN_EPS = 1e-5
RMS_EPS = 1e-6
DEEPNORM_ALPHA = (2.0 * DEPTH) ** 0.25
DEEPNORM_BETA = (8.0 * DEPTH) ** -0.25
NEG_INF = -1e30

kernel_name = "hybrid_chunked_stickbreaking_memxattn_moe"


def layer_norm(x, g, b):
    xf = x.astype(jnp.float32)
    mu = jnp.mean(xf, axis=-1, keepdims=True)
    var = jnp.mean(jnp.square(xf - mu), axis=-1, keepdims=True)
    return ((xf - mu) * lax.rsqrt(var + LN_EPS) * g + b).astype(x.dtype)


def rms_norm(x, g):
    xf = x.astype(jnp.float32)
    return (xf * lax.rsqrt(jnp.mean(jnp.square(xf), axis=-1, keepdims=True) + RMS_EPS) * g).astype(x.dtype)


def chunked_relpos_attention(q, k, v, rel_bias):
    b, h, s, dh = q.shape
    nc = s // CHUNK
    qc = q.reshape(b, h, nc, CHUNK, dh)
    pad = ((0, 0), (0, 0), (LEFT_CHUNKS * CHUNK, 0), (0, 0))
    kc = jnp.pad(k, pad).reshape(b, h, nc + LEFT_CHUNKS, CHUNK, dh)
    vc = jnp.pad(v, pad).reshape(b, h, nc + LEFT_CHUNKS, CHUNK, dh)
    k_band = jnp.concatenate([kc[:, :, o:o + nc] for o in range(LEFT_CHUNKS + 1)], axis=3)
    v_band = jnp.concatenate([vc[:, :, o:o + nc] for o in range(LEFT_CHUNKS + 1)], axis=3)
    band_pos = jnp.arange(BAND)
    key_chunk = jnp.arange(nc)[:, None] - LEFT_CHUNKS + band_pos[None, :] // CHUNK
    valid = key_chunk >= 0
    rel = LEFT_CHUNKS * CHUNK + jnp.arange(CHUNK)[:, None] - band_pos[None, :]
    rel_idx = jnp.clip(rel, -REL_CLIP, REL_CLIP) + REL_CLIP
    bias = rel_bias[:, rel_idx].astype(jnp.float32)
    scores = jnp.einsum('bhcqd,bhckd->bhcqk', qc, k_band).astype(jnp.float32) * (dh ** -0.5)
    scores = scores + bias[None, :, None]
    scores = jnp.where(valid[None, None, :, None, :], scores, NEG_INF)
    p = jax.nn.softmax(scores, axis=-1).astype(v.dtype)
    out = jnp.einsum('bhcqk,bhckd->bhcqd', p, v_band)
    return out.reshape(b, h, s, dh)


def stick_breaking_attention(q, k, v):
    b, h, s, dh = q.shape
    nb = s // SB_BLOCK
    scale = dh ** -0.5
    kf = k.astype(jnp.float32)
    vf = v.astype(jnp.float32)
    key_pos = jnp.arange(s)
    qb = q.reshape(b, h, nb, SB_BLOCK, dh).transpose(2, 0, 1, 3, 4)

    def block(args):
        q_blk, blk_idx = args
        q_pos = blk_idx * SB_BLOCK + jnp.arange(SB_BLOCK)
        causal = key_pos[None, :] < q_pos[:, None]
        z = jnp.einsum('bhqd,bhkd->bhqk', q_blk.astype(jnp.float32), kf) * scale
        log_beta = jax.nn.log_sigmoid(z)
        log_one_minus = jnp.where(causal, jax.nn.log_sigmoid(-z), 0.0)
        between = lax.cumsum(log_one_minus, axis=3, reverse=True) - log_one_minus
        weights = jnp.where(causal, jnp.exp(log_beta + between), 0.0)
        return jnp.einsum('bhqk,bhkd->bhqd', weights, vf)

    out = lax.map(block, (qb, jnp.arange(nb)))
    return out.transpose(1, 2, 0, 3, 4).reshape(b, h, s, dh).astype(q.dtype)


def hybrid_mixer(h, w_in, rel_bias, g_group_a, g_group_b, w_out):
    b, s, _ = h.shape
    proj = h @ w_in
    o1 = WIDTH_A
    o2 = 2 * WIDTH_A
    o3 = 3 * WIDTH_A
    o4 = o3 + WIDTH_B
    o5 = o3 + 2 * WIDTH_B
    qa, ka, va, qb, kb, vb = jnp.split(proj, [o1, o2, o3, o4, o5], axis=-1)

    def heads(t, n):
        return t.reshape(b, s, n, HEAD_DIM).transpose(0, 2, 1, 3)

    def merge(t):
        return t.transpose(0, 2, 1, 3).reshape(b, s, -1)

    out_a = merge(chunked_relpos_attention(heads(qa, N_HEADS_A), heads(ka, N_HEADS_A), heads(va, N_HEADS_A), rel_bias))
    out_b = merge(stick_breaking_attention(heads(qb, N_HEADS_B), heads(kb, N_HEADS_B), heads(vb, N_HEADS_B)))
    out = jnp.concatenate([rms_norm(out_a, g_group_a), rms_norm(out_b, g_group_b)], axis=-1)
    return out @ w_out


def memory_cross_attention(h, mem, w_q_mem, w_kv_mem, w_o_mem):
    b, s, d = h.shape
    m = mem.shape[1]
    q = (h @ w_q_mem).reshape(b, s, N_HEADS_MEM, HEAD_DIM_MEM)
    k, v = jnp.split(mem @ w_kv_mem, 2, axis=-1)
    k = k.reshape(b, m, N_HEADS_MEM, HEAD_DIM_MEM)
    v = v.reshape(b, m, N_HEADS_MEM, HEAD_DIM_MEM)
    scores = jnp.einsum('bqhd,bkhd->bhqk', q, k).astype(jnp.float32) * (HEAD_DIM_MEM ** -0.5)
    p = jax.nn.softmax(scores, axis=-1).astype(v.dtype)
    o = jnp.einsum('bhqk,bkhd->bqhd', p, v).reshape(b, s, d)
    return o @ w_o_mem


def moe_ffn(h, w_router, b_router, w_gate_up, b_gate_up, w_down, b_down):
    b, s, d = h.shape
    n = b * s
    x = h.reshape(n, d)
    logits = (x @ w_router + b_router).astype(jnp.float32)
    top_logits, top_idx = lax.top_k(logits, TOP_K)
    gates = jax.nn.softmax(top_logits, axis=-1)
    n_assign = n * TOP_K
    flat_expert = top_idx.reshape(-1)
    flat_token = jnp.repeat(jnp.arange(n, dtype=jnp.int32), TOP_K)
    flat_gate = gates.reshape(-1)
    order = jnp.argsort(flat_expert)
    sorted_expert = flat_expert[order]
    counts = jnp.bincount(flat_expert, length=N_EXPERTS)
    padded = (counts + MOE_BLOCK - 1) // MOE_BLOCK * MOE_BLOCK
    start = jnp.cumsum(counts) - counts
    pad_end = jnp.cumsum(padded)
    pad_start = pad_end - padded
    dest = pad_start[sorted_expert] + jnp.arange(n_assign) - start[sorted_expert]
    n_rows = n_assign + N_EXPERTS * MOE_BLOCK
    n_blocks = n_rows // MOE_BLOCK
    row_token = jnp.full((n_rows,), n, jnp.int32).at[dest].set(flat_token[order])
    row_gate = jnp.zeros((n_rows,), jnp.float32).at[dest].set(flat_gate[order])
    block_expert = jnp.minimum(
        jnp.searchsorted(pad_end, jnp.arange(n_blocks) * MOE_BLOCK, side='right'), N_EXPERTS - 1)
    x_pad = jnp.concatenate([x, jnp.zeros((1, d), x.dtype)], axis=0)
    x_rows = x_pad[row_token].reshape(n_blocks, MOE_BLOCK, d)

    def expert_block(args):
        xb, e = args
        gu = xb @ w_gate_up[e] + b_gate_up[e]
        gate, up = jnp.split(gu, 2, axis=-1)
        gate = jnp.minimum(gate, SWIGLU_LIMIT)
        up = jnp.clip(up, -SWIGLU_LIMIT, SWIGLU_LIMIT)
        glu = gate * jax.nn.sigmoid(gate * SWIGLU_ALPHA)
        return ((up + 1.0) * glu) @ w_down[e] + b_down[e]

    y_rows = lax.map(expert_block, (x_rows, block_expert)).reshape(n_rows, d)
    y = jax.ops.segment_sum(y_rows * row_gate[:, None].astype(y_rows.dtype), row_token, num_segments=n + 1)[:n]
    return y.reshape(b, s, d)


def setup_inputs(seed: int = 0) -> dict:
    key = jax.random.key(seed)
    ks = jax.random.split(key, 20)

    def normal(k, shape, scale):
        return jax.random.normal(k, shape, jnp.float32) * scale

    beta = DEEPNORM_BETA
    x = normal(ks[0], (BATCH, SEQ, D_MODEL), 1.0)
    mem = normal(ks[1], (BATCH, MEM_LEN, D_MODEL), 1.0)
    col_scale = jnp.concatenate([
        jnp.ones((2 * WIDTH_A,), jnp.float32), jnp.full((WIDTH_A,), beta, jnp.float32),
        jnp.ones((2 * WIDTH_B,), jnp.float32), jnp.full((WIDTH_B,), beta, jnp.float32)])
    w_in = normal(ks[2], (DEPTH, D_MODEL, 3 * MIX_WIDTH), D_MODEL ** -0.5) * col_scale
    rel_bias = normal(ks[3], (DEPTH, N_HEADS_A, N_REL), 0.1)
    g_group_a = 1.0 + normal(ks[4], (DEPTH, WIDTH_A), 0.01)
    g_group_b = 1.0 + normal(ks[5], (DEPTH, WIDTH_B), 0.01)
    w_out = normal(ks[6], (DEPTH, MIX_WIDTH, D_MODEL), MIX_WIDTH ** -0.5 * beta)
    w_q_mem = normal(ks[7], (DEPTH, D_MODEL, D_MODEL), D_MODEL ** -0.5)
    kv_scale = jnp.concatenate([jnp.ones((D_MODEL,), jnp.float32), jnp.full((D_MODEL,), beta, jnp.float32)])
    w_kv_mem = normal(ks[8], (DEPTH, D_MODEL, 2 * D_MODEL), D_MODEL ** -0.5) * kv_scale
    w_o_mem = normal(ks[9], (DEPTH, D_MODEL, D_MODEL), D_MODEL ** -0.5 * beta)
    w_router = normal(ks[10], (DEPTH, D_MODEL, N_EXPERTS), D_MODEL ** -0.5)
    b_router = normal(ks[11], (DEPTH, N_EXPERTS), 0.01)
    w_gate_up = normal(ks[12], (DEPTH, N_EXPERTS, D_MODEL, 2 * D_FF), D_MODEL ** -0.5)
    b_gate_up = normal(ks[13], (DEPTH, N_EXPERTS, 2 * D_FF), 0.01)
    w_down = normal(ks[14], (DEPTH, N_EXPERTS, D_FF, D_MODEL), D_FF ** -0.5 * beta)
    b_down = normal(ks[15], (DEPTH, N_EXPERTS, D_MODEL), 0.01)
    ln_g = 1.0 + normal(ks[16], (DEPTH, 3, D_MODEL), 0.01)
    ln_b = normal(ks[17], (DEPTH, 3, D_MODEL), 0.01)
    return {"x": x, "mem": mem, "w_in": w_in, "rel_bias": rel_bias, "g_group_a": g_group_a,
            "g_group_b": g_group_b, "w_out": w_out, "w_q_mem": w_q_mem, "w_kv_mem": w_kv_mem,
            "w_o_mem": w_o_mem, "w_router": w_router, "b_router": b_router, "w_gate_up": w_gate_up,
            "b_gate_up": b_gate_up, "w_down": w_down, "b_down": b_down, "ln_g": ln_g, "ln_b": ln_b}


def reference(x, mem, w_in, rel_bias, g_group_a, g_group_b, w_out, w_q_mem, w_kv_mem, w_o_mem,
              w_router, b_router, w_gate_up, b_gate_up, w_down, b_down, ln_g, ln_b):
    for l in range(DEPTH):
        mix = hybrid_mixer(x, w_in[l], rel_bias[l], g_group_a[l], g_group_b[l], w_out[l])
        x = layer_norm(DEEPNORM_ALPHA * x + mix, ln_g[l, 0], ln_b[l, 0])
        xa = memory_cross_attention(x, mem, w_q_mem[l], w_kv_mem[l], w_o_mem[l])
        x = layer_norm(DEEPNORM_ALPHA * x + xa, ln_g[l, 1], ln_b[l, 1])
        ff = moe_ffn(x, w_router[l], b_router[l], w_gate_up[l], b_gate_up[l], w_down[l], b_down[l])
        x = layer_norm(DEEPNORM_ALPHA * x + ff, ln_g[l, 2], ln_b[l, 2])
    return x
```

```cpp
#include <hip/hip_runtime.h>
#include <cstdio>
#include <cstdint>

#define GAS __attribute__((address_space(1)))
#define LAS __attribute__((address_space(3)))
typedef unsigned short bf16;
typedef unsigned v4u __attribute__((ext_vector_type(4)));
typedef unsigned v2u __attribute__((ext_vector_type(2)));
typedef float f32x4 __attribute__((ext_vector_type(4)));
typedef float f32x2 __attribute__((ext_vector_type(2)));
typedef float f32x16 __attribute__((ext_vector_type(16)));
typedef short bf16x8 __attribute__((ext_vector_type(8)));
typedef short s16x4 __attribute__((ext_vector_type(4)));
typedef __bf16 bf16x2_t __attribute__((ext_vector_type(2)));

constexpr int BATCH = 2, SEQ = 8192, D = 1024, M = BATCH * SEQ;
constexpr int NQKV = 3072, CHUNK = 64, LEFT = 8, NREL = 257;
constexpr int MEMLEN = 256, MEMROWS = BATCH * MEMLEN, HDM = 256;
constexpr int NEXP = 32, TOPK = 4, DFF = 1024, CAP = 16384;
constexpr int HROWS = M * TOPK + NEXP * 256;
constexpr float LN_EPS = 1e-5f, RMS_EPS = 1e-6f;
constexpr float ALPHA = 1.189207115002721f;
constexpr float LOG2E = 1.4426950408889634f, LN2 = 0.6931471805599453f;
#ifndef SB_EXIT
#define SB_EXIT 1
#endif
constexpr float SB_EXIT_T = 104.0f;

namespace pg8 {
constexpr int BM = 256, BK = 64, HALF = 128, HTB = HALF * BK * 2, STAGE_BYTES = 8 * HTB, NXCD = 8, WGM = 8;
__host__ __device__ __forceinline__ int lds_byte(int r, int c) { const int st = (r >> 4) * 2 + (c >> 5), rr = r & 15, cc = c & 31, ob = rr * 64 + cc * 2; return st * 1024 + (ob ^ (((ob >> 9) & 1) << 5)); }
__host__ __device__ __forceinline__ void stage_rc(int b, int& R, int& C) { const int st = b / 1024, sb = b % 1024, swz = sb ^ (((sb >> 9) & 1) << 5); R = (st >> 1) * 16 + swz / 64; C = (st & 1) * 32 + (swz % 64) / 2; }
__host__ __device__ __forceinline__ int perm32(int rho) { const int n = rho >> 4, i = rho & 15; return 8 * (i >> 2) + 4 * n + (i & 3); }

struct Unit { int pm, pn, e, lrow, cnt, pad; size_t boff; };
struct Gemm { const bf16* A; const bf16* Bt; int M, N, K; const int* lst; };

struct StaticOrder {
    int nM, nN, nwg, G, c;
    __device__ void init(int M_, int N_, int G_, int c_) { nM = M_ / BM; nN = N_ / BM; nwg = nM * nN; G = G_; c = c_; }
    __device__ bool next(int i, Unit& u) const {
        const long L = (long)i * G + c; if (L >= nwg) return false;
        int wgid = (int)L; { const int q = nwg / NXCD, r = nwg % NXCD, xcd = wgid % NXCD, off = wgid / NXCD; wgid = (xcd < r ? xcd * (q + 1) : r * (q + 1) + (xcd - r) * q) + off; }
        const int nig = WGM * nN, gid = wgid / nig, fm = gid * WGM, gsz = (nM - fm) < WGM ? (nM - fm) : WGM;
        u.pm = fm + ((wgid % nig) % gsz); u.pn = (wgid % nig) / gsz; u.e = 0; u.lrow = 0; u.cnt = 256; u.pad = 0; u.boff = 0; return true;
    }
};
struct GroupOrder {
    const LAS int* tab; int npn, total, G, c; size_t bstride;
    __device__ bool next(int i, Unit& u) const {
        const int U = i * G + c; if (U >= total) return false;
        int e = 0; while (e < NEXP - 1 && __builtin_amdgcn_readfirstlane(tab[e + 1]) * npn <= U) ++e;
        const int t0 = __builtin_amdgcn_readfirstlane(tab[e]), t1 = __builtin_amdgcn_readfirstlane(tab[e + 1]), ce = __builtin_amdgcn_readfirstlane(tab[64 + e]);
        const int idx = U - t0 * npn, Te = t1 - t0, lt = idx % Te, pn = idx / Te;
        u.pm = t0 + lt; u.pn = pn; u.e = e; u.lrow = e * CAP + lt * 256; const int rem = ce - lt * 256; u.cnt = rem < 256 ? rem : 256; u.pad = 0; u.boff = (size_t)e * bstride; return true;
    }
};

__device__ __forceinline__ unsigned cvt_pk_bf16(float lo, float hi) { f32x2 v = {lo, hi}; bf16x2_t b = __builtin_convertvector(v, bf16x2_t); return __builtin_bit_cast(unsigned, b); }

struct EpiBf16 {
    static constexpr bool PERM = true;
    bf16* O; int ldc;
    __device__ __forceinline__ void operator()(const f32x4 (&acc)[2][2][4][2], const Unit& u, int wr, int wc, int fr, int fq) const {
        const int row0 = u.pm * BM + wr * 64 + fr, col0 = u.pn * BM + wc * 32 + 8 * fq;
#pragma unroll
        for (int ai = 0; ai < 2; ++ai)
#pragma unroll
            for (int m = 0; m < 4; ++m) { bf16* rowp = O + (size_t)(row0 + ai * HALF + m * 16) * ldc + col0;
#pragma unroll
                for (int bj = 0; bj < 2; ++bj) { const f32x4 v0 = acc[ai][bj][m][0], v1 = acc[ai][bj][m][1];
                    v4u w; w.x = cvt_pk_bf16(v0[0], v0[1]); w.y = cvt_pk_bf16(v0[2], v0[3]); w.z = cvt_pk_bf16(v1[0], v1[1]); w.w = cvt_pk_bf16(v1[2], v1[3]);
                    *(v4u*)(rowp + bj * HALF) = w; } }
    }
};
struct EpiResF32 {
    static constexpr bool PERM = false;
    float* C; const float* res; int ldc; float alpha;
    __device__ __forceinline__ void operator()(const f32x4 (&acc)[2][2][4][2], const Unit& u, int wr, int wc, int fr, int fq) const {
        const int row0 = u.pm * BM + wr * 64 + fr, col0 = u.pn * BM + wc * 32 + 4 * fq;
#pragma unroll
        for (int ai = 0; ai < 2; ++ai)
#pragma unroll
            for (int m = 0; m < 4; ++m) { const size_t off = (size_t)(row0 + ai * HALF + m * 16) * ldc + col0;
#pragma unroll
                for (int bj = 0; bj < 2; ++bj)
#pragma unroll
                    for (int n = 0; n < 2; ++n) { const f32x4 r = *(const f32x4*)(res + off + bj * HALF + n * 16); *(f32x4*)(C + off + bj * HALF + n * 16) = r * alpha + acc[ai][bj][m][n]; } }
    }
};
struct EpiSwiglu {
    static constexpr bool PERM = true;
    bf16* H; const float* bias;
    __device__ __forceinline__ void operator()(const f32x4 (&acc)[2][2][4][2], const Unit& u, int wr, int wc, int fr, int fq) const {
        const int row0 = u.pm * BM + wr * 64 + fr, cc = u.pn * HALF + wc * 32 + 8 * fq;
        const float* bg = bias + (size_t)u.e * (2 * DFF) + cc; const float* bu = bg + DFF;
        f32x4 bgv[2], buv[2];
#pragma unroll
        for (int n = 0; n < 2; ++n) { bgv[n] = *(const f32x4*)(bg + 4 * n); buv[n] = *(const f32x4*)(bu + 4 * n); }
#pragma unroll
        for (int ai = 0; ai < 2; ++ai)
#pragma unroll
            for (int m = 0; m < 4; ++m) { float o[8];
#pragma unroll
                for (int n = 0; n < 2; ++n)
#pragma unroll
                    for (int j = 0; j < 4; ++j) { float g = acc[ai][0][m][n][j] + bgv[n][j], up = acc[ai][1][m][n][j] + buv[n][j];
                        g = fminf(g, 7.0f); up = fminf(fmaxf(up, -7.0f), 7.0f);
                        const float glu = g * __builtin_amdgcn_rcpf(1.0f + __builtin_amdgcn_exp2f(-1.702f * LOG2E * g));
                        o[4 * n + j] = (up + 1.0f) * glu; }
                v4u w; w.x = cvt_pk_bf16(o[0], o[1]); w.y = cvt_pk_bf16(o[2], o[3]); w.z = cvt_pk_bf16(o[4], o[5]); w.w = cvt_pk_bf16(o[6], o[7]);
                *(v4u*)(H + (size_t)(row0 + ai * HALF + m * 16) * DFF + cc) = w; }
    }
};
struct EpiDown {
    static constexpr bool PERM = true;
    bf16* YS; const float* bias; const int* lslot; const float* lgate;
    __device__ __forceinline__ void operator()(const f32x4 (&acc)[2][2][4][2], const Unit& u, int wr, int wc, int fr, int fq) const {
        const int col0 = u.pn * BM + wc * 32 + 8 * fq;
        f32x4 bv[2][2];
#pragma unroll
        for (int bj = 0; bj < 2; ++bj)
#pragma unroll
            for (int n = 0; n < 2; ++n) bv[bj][n] = *(const f32x4*)(bias + (size_t)u.e * D + col0 + bj * HALF + 4 * n);
#pragma unroll
        for (int ai = 0; ai < 2; ++ai)
#pragma unroll
            for (int m = 0; m < 4; ++m) { const int r = ai * HALF + wr * 64 + m * 16 + fr;
                if (r < u.cnt) { const int slot = lslot[u.lrow + r]; const float gt = lgate[u.lrow + r]; bf16* rowp = YS + (size_t)slot * D + col0;
#pragma unroll
                    for (int bj = 0; bj < 2; ++bj) { const f32x4 v0 = (acc[ai][bj][m][0] + bv[bj][0]) * gt, v1 = (acc[ai][bj][m][1] + bv[bj][1]) * gt;
                        v4u w; w.x = cvt_pk_bf16(v0[0], v0[1]); w.y = cvt_pk_bf16(v0[2], v0[3]); w.z = cvt_pk_bf16(v1[0], v1[1]); w.w = cvt_pk_bf16(v1[2], v1[3]);
                        *(v4u*)(rowp + bj * HALF) = w; } } }
    }
};

template <class Epi, class Sched, bool GATHER, bool ALIGN_EPI>
__device__ __forceinline__ void gemm_phase(LAS unsigned char* lds, const Gemm g, const Sched& S, const Epi& E) {
    const int tid = threadIdx.x, wid = __builtin_amdgcn_readfirstlane(tid >> 6), lane = tid & 63, wr = wid >> 2, wc = wid & 3, fr = lane & 15, fq = lane >> 4;
    const int K = g.K, nt = K / BK;
    unsigned voffB[2]; int RA[2]; unsigned CA2[2];
#pragma unroll
    for (int i = 0; i < 2; ++i) { int R, C; stage_rc(tid * 16 + i * 8192, R, C); const int Rb = Epi::PERM ? ((R & ~31) + perm32(R & 31)) : R;
        voffB[i] = (unsigned)(Rb * K + C) * 2u; RA[i] = R; CA2[i] = (unsigned)C * 2u; }
    const size_t kstep = (size_t)(BK * 2);
    const size_t hstep = (size_t)HALF * K * 2;
    const size_t tstep = 2 * hstep;
    const unsigned ldsw = (unsigned)wid * 1024u;
    const int aoff = lds_byte(wr * 64 + fr, fq * 8), boff = lds_byte(wc * 32 + fr, fq * 8);
#define PG8_SA(b, h) (((b) * 2 + (h)) * HTB)
#define PG8_SB(b, h) ((4 + (b) * 2 + (h)) * HTB)
#define PG8_STAGE_B(bufoff, gbase) do { _Pragma("unroll") for (int _i = 0; _i < 2; ++_i) \
        __builtin_amdgcn_global_load_lds((const unsigned*)((const char*)(gbase) + voffB[_i]), (LAS unsigned*)(lds + (bufoff) + ldsw + _i * 8192), 16, 0, 0); } while (0)
#define PG8_STAGE_A(bufoff, gbase, AO, h) do { _Pragma("unroll") for (int _i = 0; _i < 2; ++_i) \
        __builtin_amdgcn_global_load_lds((const unsigned*)((const char*)(gbase) + AO[h][_i]), (LAS unsigned*)(lds + (bufoff) + ldsw + _i * 8192), 16, 0, 0); } while (0)
#define PG8_SETA(AO, U) do { _Pragma("unroll") for (int _h = 0; _h < 2; ++_h) _Pragma("unroll") for (int _i = 0; _i < 2; ++_i) { \
        if (GATHER) { const int _rr = _h * HALF + RA[_i]; int _tok = 0; if (_rr < (U).cnt) _tok = g.lst[(U).lrow + _rr] >> 2; AO[_h][_i] = (unsigned)_tok * (unsigned)(K * 2) + CA2[_i]; } \
        else AO[_h][_i] = (unsigned)(_h * (int)hstep) + (unsigned)(RA[_i] * K * 2) + CA2[_i]; } } while (0)
#define PG8_LDA(dst, b, h) do { _Pragma("unroll") for (int m = 0; m < 4; ++m) _Pragma("unroll") for (int k = 0; k < 2; ++k) dst[m][k] = *(const LAS bf16x8*)(lds + PG8_SA(b, h) + aoff + m * 2048 + k * 1024); } while (0)
#define PG8_LDB(dst, b, h) do { _Pragma("unroll") for (int n = 0; n < 2; ++n) _Pragma("unroll") for (int k = 0; k < 2; ++k) dst[n][k] = *(const LAS bf16x8*)(lds + PG8_SB(b, h) + boff + n * 2048 + k * 1024); } while (0)
#define PG8_MMA(ai, bj, At, Bt) do { __builtin_amdgcn_s_setprio(1); _Pragma("unroll") for (int m = 0; m < 4; ++m) _Pragma("unroll") for (int n = 0; n < 2; ++n) _Pragma("unroll") for (int k = 0; k < 2; ++k) \
        acc[ai][bj][m][n] = __builtin_amdgcn_mfma_f32_16x16x32_bf16(Bt[n][k], At[m][k], acc[ai][bj][m][n], 0, 0, 0); __builtin_amdgcn_s_setprio(0); } while (0)
#define PG8_WAIT_V(n) asm volatile("s_waitcnt vmcnt(" #n ")" ::: "memory")
#define PG8_WAIT_L(n) asm volatile("s_waitcnt lgkmcnt(" #n ")" ::: "memory")
#define PG8_BAR __builtin_amdgcn_s_barrier()
#define PG8_SCHED __builtin_amdgcn_sched_barrier(0)
    Unit cur, nxt; int ui = 0;
    if (!S.next(0, cur)) return;
    f32x4 acc[2][2][4][2];
#pragma unroll
    for (int a = 0; a < 2; ++a)
#pragma unroll
        for (int b = 0; b < 2; ++b)
#pragma unroll
            for (int m = 0; m < 4; ++m)
#pragma unroll
                for (int n = 0; n < 2; ++n) acc[a][b][m][n] = (f32x4){0.f, 0.f, 0.f, 0.f};
    bf16x8 At[4][2], B0[2][2], B1[2][2];
    unsigned aC[2][2], aN[2][2];
    PG8_SETA(aC, cur);
    const char* cA = GATHER ? (const char*)g.A : (const char*)g.A + (size_t)cur.pm * tstep;
    const char* cB = (const char*)g.Bt + cur.boff + (size_t)cur.pn * tstep;
    PG8_STAGE_B(PG8_SB(0, 0), cB); PG8_STAGE_B(PG8_SB(0, 1), cB + hstep); PG8_STAGE_A(PG8_SA(0, 0), cA, aC, 0); PG8_STAGE_A(PG8_SA(0, 1), cA, aC, 1);
    if (wr == 1) PG8_BAR;
    PG8_WAIT_V(2); PG8_BAR;
    PG8_STAGE_B(PG8_SB(1, 0), cB + kstep); PG8_STAGE_A(PG8_SA(1, 0), cA + kstep, aC, 0); PG8_STAGE_B(PG8_SB(1, 1), cB + hstep + kstep);
    PG8_WAIT_V(6); PG8_BAR;
    for (;;) {
        const bool has_next = S.next(ui + 1, nxt);
        const char* nA = cA; const char* nB = cB;
        if (has_next) { nA = GATHER ? (const char*)g.A : (const char*)g.A + (size_t)nxt.pm * tstep; nB = (const char*)g.Bt + nxt.boff + (size_t)nxt.pn * tstep; PG8_SETA(aN, nxt); }
        else {
#pragma unroll
            for (int h = 0; h < 2; ++h)
#pragma unroll
                for (int i = 0; i < 2; ++i) aN[h][i] = aC[h][i]; }
        for (int t = 0; t < nt; t += 2) {
            const bool last = (t == nt - 2);
            const char* a1 = cA + (size_t)(t + 1) * kstep;
            const char* a2 = last ? nA : cA + (size_t)(t + 2) * kstep; const char* b2 = last ? nB : cB + (size_t)(t + 2) * kstep;
            const char* a3 = a2 + kstep; const char* b3 = b2 + kstep;
            unsigned aX[2][2];
#pragma unroll
            for (int h = 0; h < 2; ++h)
#pragma unroll
                for (int i = 0; i < 2; ++i) aX[h][i] = (GATHER && last) ? aN[h][i] : aC[h][i];
            PG8_LDB(B0, 0, 0); PG8_LDB(B1, 0, 1); PG8_SCHED; PG8_LDA(At, 0, 0); PG8_STAGE_A(PG8_SA(1, 1), a1, aC, 1);
            PG8_WAIT_V(8); PG8_WAIT_L(0); PG8_BAR; PG8_MMA(0, 0, At, B0); PG8_MMA(0, 1, At, B1); PG8_BAR; PG8_SCHED;
            PG8_LDA(At, 0, 1); PG8_STAGE_B(PG8_SB(0, 0), b2); PG8_STAGE_B(PG8_SB(0, 1), b2 + hstep); PG8_STAGE_A(PG8_SA(0, 0), a2, aX, 0);
            PG8_WAIT_V(8); PG8_WAIT_L(0); PG8_BAR; PG8_MMA(1, 0, At, B0); PG8_MMA(1, 1, At, B1); PG8_BAR; PG8_SCHED;
            PG8_LDB(B0, 1, 0); PG8_LDB(B1, 1, 1); PG8_SCHED; PG8_LDA(At, 1, 0); PG8_STAGE_A(PG8_SA(0, 1), a2, aX, 1);
            PG8_WAIT_V(8); PG8_WAIT_L(0); PG8_BAR; PG8_MMA(0, 0, At, B0); PG8_MMA(0, 1, At, B1); PG8_BAR; PG8_SCHED;
            PG8_LDA(At, 1, 1); PG8_STAGE_B(PG8_SB(1, 0), b3); PG8_STAGE_B(PG8_SB(1, 1), b3 + hstep); PG8_STAGE_A(PG8_SA(1, 0), a3, aX, 0);
            PG8_WAIT_V(8); PG8_WAIT_L(0); PG8_BAR; PG8_MMA(1, 0, At, B0); PG8_MMA(1, 1, At, B1); PG8_BAR; PG8_SCHED;
        }
        if constexpr (ALIGN_EPI) { if (wr == 0) PG8_BAR; }
        E(acc, cur, wr, wc, fr, fq);
        if (!has_next) break;
#pragma unroll
        for (int a = 0; a < 2; ++a)
#pragma unroll
            for (int b = 0; b < 2; ++b)
#pragma unroll
                for (int m = 0; m < 4; ++m)
#pragma unroll
                    for (int n = 0; n < 2; ++n) acc[a][b][m][n] = (f32x4){0.f, 0.f, 0.f, 0.f};
        cur = nxt; cA = nA; cB = nB; ++ui;
#pragma unroll
        for (int h = 0; h < 2; ++h)
#pragma unroll
            for (int i = 0; i < 2; ++i) aC[h][i] = aN[h][i];
        if constexpr (ALIGN_EPI) { if (wr == 1) PG8_BAR; }
    }
    PG8_WAIT_V(0);
    if constexpr (!ALIGN_EPI) { if (wr == 0) PG8_BAR; }
    PG8_BAR;
#undef PG8_SA
#undef PG8_SB
#undef PG8_STAGE_A
#undef PG8_STAGE_B
#undef PG8_SETA
#undef PG8_LDA
#undef PG8_LDB
#undef PG8_MMA
#undef PG8_WAIT_V
#undef PG8_WAIT_L
#undef PG8_BAR
#undef PG8_SCHED
}
}

constexpr int NWAVES = 8;
#ifndef MK_N_LAUNCHES
#define MK_N_LAUNCHES 1
#endif
constexpr int PER_PHASE = 12;
constexpr int N_LAUNCHES = MK_N_LAUNCHES;

constexpr size_t MiB = 1u << 20;
constexpr size_t WS_CTL = 0, CTL_ZERO_BYTES = 1 * MiB;
constexpr size_t WS_WIN = 2 * MiB, WS_WOUT = 8 * MiB, WS_WQ = 10 * MiB, WS_WKV = 12 * MiB, WS_WO = 16 * MiB;
constexpr size_t WS_MEMB = 18 * MiB, WS_KVM = 19 * MiB, WS_LSLOT = 21 * MiB, WS_LGATE = 23 * MiB, WS_WRH = 25 * MiB, WS_WRL = 25 * MiB + 65536;
constexpr size_t WS_WGU = 32 * MiB, WS_WD = 160 * MiB;
constexpr size_t WS_XB = 224 * MiB, WS_QKV = 256 * MiB, WS_MIXN = 352 * MiB, WS_Y = 384 * MiB, WS_X1 = 448 * MiB, WS_X1B = 512 * MiB;
constexpr size_t WS_QM = 544 * MiB, WS_OM = 576 * MiB, WS_X2 = 608 * MiB, WS_X2B = 672 * MiB, WS_END = 704 * MiB;
constexpr size_t WS_H = 224 * MiB;
constexpr size_t WS_YS = 384 * MiB;
static_assert(WS_H + (size_t)HROWS * DFF * 2 <= WS_Y && WS_YS + (size_t)M * TOPK * D * 2 <= WS_X1B, "overlay map");
constexpr int CW_TMO = 0, CW_BAR = 4096, CW_CNT = 8192;

constexpr int RING_OFF = 0, RING_BYTES = 131072;
constexpr int LDSCTL_OFF = RING_BYTES, MISC_OFF = LDSCTL_OFF + 320;
constexpr int TAB_OFF = LDSCTL_OFF + 512;
constexpr int P8_TK_OFF = LDSCTL_OFF + 1024;
constexpr int LDS_BYTES = 147456;
static_assert(P8_TK_OFF + 3 * 1024 + 256 <= LDS_BYTES && 4 * 64 * 33 * 4 <= RING_BYTES, "LDS map");
constexpr int VT_PITCH = 144, VT_BYTES = 64 * VT_PITCH;
constexpr int A_BIAS_OFF = 8 * VT_BYTES;
constexpr int A_SSQ_OFF = A_BIAS_OFF + 8 * 260 * 4;
static_assert(A_SSQ_OFF + 2 * 8 * 64 * 4 <= RING_BYTES, "mixer LDS");
constexpr int XV_PITCH = 528, XV_BYTES = 64 * XV_PITCH;

typedef GAS unsigned gu32;
#define RLX_AGENT __ATOMIC_RELAXED, __HIP_MEMORY_SCOPE_AGENT
#define LDS_WAIT() asm volatile("s_waitcnt lgkmcnt(0)" ::: "memory")
#define VM_WAIT() asm volatile("s_waitcnt vmcnt(0)" ::: "memory")
__device__ __forceinline__ unsigned pk2(float lo, float hi) { return pg8::cvt_pk_bf16(lo, hi); }
__device__ __forceinline__ float bf2f(unsigned short h) { return __uint_as_float(((unsigned)h) << 16); }
#define MFMA32(a, b, c) __builtin_amdgcn_mfma_f32_32x32x16_bf16((a), (b), (c), 0, 0, 0)
__device__ __forceinline__ int crow(int reg, int h) { return (reg & 3) + 8 * (reg >> 2) + 4 * h; }
__device__ __forceinline__ s16x4 vtr(LAS const unsigned char* p) { return __builtin_bit_cast(s16x4, __builtin_amdgcn_ds_read_tr16_b64_v4i16((LAS s16x4*)p)); }
__device__ __forceinline__ bf16x8 pack8(const f32x16& x, int s) {
    v4u p; p.x = pk2(x[8 * s], x[8 * s + 1]); p.y = pk2(x[8 * s + 2], x[8 * s + 3]); p.z = pk2(x[8 * s + 4], x[8 * s + 5]); p.w = pk2(x[8 * s + 6], x[8 * s + 7]);
    return __builtin_bit_cast(bf16x8, p);
}

#define XB_TMO      128
#define XB_XCNT(j)  (256  + 64 * (j))
#define XB_XSUB(j)  (1280 + 64 * (j))
#define XB_XGEN(j)  (2304 + 64 * (j))
#define XB_TOP      3328
#define XB_TOPGEN   3392
#define XCD_BAR_WORDS 3456
#define XB_SPIN_CAP (1u << 18)
__device__ __forceinline__ unsigned xb_ld(unsigned* p)              { return __hip_atomic_load(p, __ATOMIC_RELAXED, __HIP_MEMORY_SCOPE_AGENT); }
__device__ __forceinline__ unsigned xb_add(unsigned* p, unsigned v) { return __hip_atomic_fetch_add(p, v, __ATOMIC_RELAXED, __HIP_MEMORY_SCOPE_AGENT); }
__device__ __forceinline__ unsigned xb_xcc_id() { return (unsigned)__builtin_amdgcn_s_getreg((3 << 11) | 20) & 0xFu; }
#define XB_SPIN(cond, bar) do { unsigned _sp = 0; while (cond) { __builtin_amdgcn_s_sleep(1); \
    if ((++_sp & 255u) == 0u) { if (xb_ld(&(bar)[XB_TMO])) break; if (_sp > XB_SPIN_CAP) { atomicAdd(&(bar)[XB_TMO], 1u); break; } } } } while (0)
struct XcdBarrier { unsigned* bar; unsigned x; volatile LAS unsigned* st; };
__device__ __forceinline__ XcdBarrier xcd_barrier_post(unsigned* bar, volatile LAS unsigned* st) {
    XcdBarrier b; b.bar = bar; b.x = xb_xcc_id(); b.st = st;
    if (threadIdx.x == 0) (void)xb_add(&bar[XB_XCNT(b.x)], 1u);
    return b;
}
__device__ __forceinline__ void xcd_barrier_complete(unsigned* bar, unsigned x, unsigned& nloc, unsigned& nx) {
    const unsigned G = gridDim.x * gridDim.y * gridDim.z;
    unsigned sum, cnt, mine, sp = 0u;
    for (;;) {
        sum = 0u; cnt = 0u; mine = 0u;
#pragma unroll
        for (unsigned j = 0; j < 16; ++j) { const unsigned c = xb_ld(&bar[XB_XCNT(j)]); sum += c; cnt += (c > 0u) ? 1u : 0u; mine = (j == x) ? c : mine; }
        if (sum == G) break;
        __builtin_amdgcn_s_sleep(1);
        if ((++sp & 255u) == 0u) { if (xb_ld(&bar[XB_TMO])) break; if (sp > XB_SPIN_CAP) { atomicAdd(&bar[XB_TMO], 1u); break; } }
    }
    nloc = mine > 0u ? mine : 1u; nx = cnt > 0u ? cnt : 1u;
}
__device__ __forceinline__ void xcd_barrier(const XcdBarrier& b) {
    asm volatile("s_waitcnt vmcnt(0)" ::: "memory");
    __syncthreads();
    if (threadIdx.x == 0) {
        unsigned* bar = b.bar;
        __builtin_amdgcn_s_waitcnt(0);
        unsigned nloc = b.st[0], nx = b.st[1];
        if (nloc == 0u) { xcd_barrier_complete(bar, b.x, nloc, nx); b.st[0] = nloc; b.st[1] = nx; }
        const unsigned old = xb_add(&bar[XB_XSUB(b.x)], 1u);
        const unsigned gen = old / nloc;
        if (old + 1u == (gen + 1u) * nloc) {
            __builtin_amdgcn_fence(__ATOMIC_RELEASE, "agent");
            asm volatile("s_waitcnt vmcnt(0)" ::: "memory");
            const unsigned og = xb_add(&bar[XB_TOP], 1u);
            const unsigned tg = og / nx;
            if (og + 1u == (tg + 1u) * nx) xb_add(&bar[XB_TOPGEN], 1u);
            else XB_SPIN(xb_ld(&bar[XB_TOPGEN]) == tg, bar);
            __builtin_amdgcn_fence(__ATOMIC_ACQUIRE, "agent");
            xb_add(&bar[XB_XGEN(b.x)], 1u);
            asm volatile("s_waitcnt vmcnt(0)" ::: "memory");
        } else {
            XB_SPIN(xb_ld(&bar[XB_XGEN(b.x)]) == gen, bar);
            __builtin_amdgcn_fence(__ATOMIC_ACQUIRE, "agent");
            asm volatile("s_waitcnt vmcnt(0)" ::: "memory");
        }
    }
    __syncthreads();
}

struct Frame {
    LAS unsigned char* lds;
    volatile LAS unsigned* MISC;
    gu32* ctl;
    int tid, lane, wave;
    int vcu, G;
    const float *x, *mem, *w_in, *rel_bias, *g_a, *g_b, *w_out, *w_q, *w_kv, *w_o, *w_router, *b_router, *w_gu, *b_gu, *w_down, *b_down, *ln_g, *ln_b;
    float* out;
    bf16 *Win_t, *Wout_t, *Wq_t, *Wkv_t, *Wo_t, *Wgu_t, *Wd_t, *WRH, *WRL;
    bf16 *XB, *MEMB, *KVM, *QKV, *MIXN, *X1B, *QM, *OM, *X2B, *H, *YS;
    float *Y, *X1, *X2, *LGATE;
    int* LSLOT;
};

__device__ __forceinline__ float wave_sum(float v) {
#pragma unroll
    for (int o = 1; o < 64; o <<= 1) v += __shfl_xor(v, o);
    return v;
}

template <int RM>
__device__ __forceinline__ void p0_transpose_item(const float* W, int K, int N, bf16* WT, const float* ksc, LAS float* scr, int item, int lane) {
    const int nblk = N / 32, kb = item / nblk, nb = item % nblk, k0 = 64 * kb, n0 = 32 * nb;
#pragma unroll 8
    for (int i = 0; i < 32; ++i) { const int kk = 2 * i + (lane >> 5); float v = W[(size_t)(k0 + kk) * N + n0 + (lane & 31)]; if (ksc) v *= ksc[k0 + kk]; scr[kk * 33 + (lane & 31)] = v; }
    LDS_WAIT(); asm volatile("" ::: "memory");
    const int c = lane & 7;
    int d0 = n0;
    if (RM == 1) { const int t = n0 >> 10, rem = n0 & 1023, p = rem >> 7, j = rem & 127; d0 = 256 * p + 128 * t + j; }
#pragma unroll
    for (int j = 0; j < 4; ++j) { const int n = (lane >> 3) + 8 * j; const LAS float* s = scr + (8 * c) * 33 + n;
        v4u o; o.x = pk2(s[0 * 33], s[1 * 33]); o.y = pk2(s[2 * 33], s[3 * 33]); o.z = pk2(s[4 * 33], s[5 * 33]); o.w = pk2(s[6 * 33], s[7 * 33]);
        *(GAS v4u*)(WT + (size_t)(d0 + n) * K + k0 + 8 * c) = o; }
    LDS_WAIT(); asm volatile("" ::: "memory");
}
__device__ __forceinline__ void row_to_bf16(const float* xrow, bf16* orow, int lane) {
    const GAS f32x4* xr = (const GAS f32x4*)xrow + lane;
    GAS v2u* o8 = (GAS v2u*)orow + lane;
#pragma unroll
    for (int j = 0; j < 4; ++j) { const f32x4 v = xr[64 * j]; v2u w; w.x = pk2(v.x, v.y); w.y = pk2(v.z, v.w); o8[64 * j] = w; }
}
__device__ __forceinline__ void p0_prologue(Frame& F) {
    LAS float* scr = (LAS float*)(F.lds + RING_OFF + F.wave * 16384);
    const int gw = F.vcu * NWAVES + F.wave, NGW = F.G * NWAVES;
    constexpr int I_IN = (D / 64) * (NQKV / 32), I_SQ = (D / 64) * (D / 32), I_KV = (D / 64) * (2 * D / 32), I_GU = (D / 64) * (2 * DFF / 32), I_DN = (DFF / 64) * (D / 32);
    constexpr int NITEMS = I_IN + 3 * I_SQ + I_KV + NEXP * (I_GU + I_DN);
    for (int it = gw; it < NITEMS; it += NGW) {
        int r = it;
        if (r < I_IN) { p0_transpose_item<0>(F.w_in, D, NQKV, F.Win_t, nullptr, scr, r, F.lane); continue; } r -= I_IN;
        if (r < I_SQ) { const int kb = r / (D / 32); p0_transpose_item<0>(F.w_out, D, D, F.Wout_t, kb < 8 ? F.g_a : F.g_b - 512, scr, r, F.lane); continue; } r -= I_SQ;
        if (r < I_SQ) { p0_transpose_item<0>(F.w_q, D, D, F.Wq_t, nullptr, scr, r, F.lane); continue; } r -= I_SQ;
        if (r < I_SQ) { p0_transpose_item<0>(F.w_o, D, D, F.Wo_t, nullptr, scr, r, F.lane); continue; } r -= I_SQ;
        if (r < I_KV) { p0_transpose_item<0>(F.w_kv, D, 2 * D, F.Wkv_t, nullptr, scr, r, F.lane); continue; } r -= I_KV;
        if (r < NEXP * I_GU) { const int e = r / I_GU; p0_transpose_item<1>(F.w_gu + (size_t)e * D * 2 * DFF, D, 2 * DFF, F.Wgu_t + (size_t)e * 2 * DFF * D, nullptr, scr, r % I_GU, F.lane); continue; } r -= NEXP * I_GU;
        { const int e = r / I_DN; p0_transpose_item<0>(F.w_down + (size_t)e * DFF * D, DFF, D, F.Wd_t + (size_t)e * D * DFF, nullptr, scr, r % I_DN, F.lane); }
    }
    for (int m = gw; m < M; m += NGW) row_to_bf16(F.x + (size_t)m * D, F.XB + (size_t)m * D, F.lane);
    for (int m = gw; m < MEMROWS; m += NGW) row_to_bf16(F.mem + (size_t)m * D, F.MEMB + (size_t)m * D, F.lane);
    for (int i = F.vcu * (NWAVES * 64) + F.tid; i < NEXP * D; i += F.G * NWAVES * 64) {
        const int e = i >> 10, k = i & 1023; const float v = F.w_router[k * NEXP + e];
        const unsigned h = pk2(v, 0.f) & 0xffffu; const float r = v - bf2f((unsigned short)h);
        F.WRH[i] = (bf16)h; F.WRL[i] = (bf16)(pk2(r, 0.f) & 0xffffu); }
}

__device__ __forceinline__ void load_v_tile(v4u (&t)[8], const bf16* vsrc  , int ld, int lane) {
#pragma unroll
    for (int i = 0; i < 8; ++i) { const int p = lane + 64 * i, key = p >> 3, seg = p & 7; t[i] = *(const GAS v4u*)(vsrc + (size_t)key * ld + seg * 8); }
}
__device__ __forceinline__ void write_v_tile(LAS unsigned char* vt, const v4u (&t)[8], int lane) {
#pragma unroll
    for (int i = 0; i < 8; ++i) { const int p = lane + 64 * i, key = p >> 3, seg = p & 7; *(LAS v4u*)(vt + key * VT_PITCH + seg * 16) = t[i]; }
    asm volatile("" ::: "memory");
}
__device__ __forceinline__ void pv_tile64(f32x16& o0, f32x16& o1, const f32x16& p0, const f32x16& p1, LAS const unsigned char* vt, int lane) {
    const int hi = lane >> 5, i16 = lane & 15, q4 = i16 >> 2, p4 = i16 & 3, blk = (lane >> 4) & 1;
    LAS const unsigned char* vb = vt + (4 * hi + q4) * VT_PITCH + (16 * blk + 4 * p4) * 2;
#pragma unroll
    for (int ks = 0; ks < 4; ++ks) {
        const bf16x8 pf = pack8((ks >> 1) ? p1 : p0, ks & 1);
        const int kb = 32 * (ks >> 1) + 16 * (ks & 1);
#pragma unroll
        for (int db = 0; db < 2; ++db) {
            const s16x4 lo = vtr(vb + kb * VT_PITCH + db * 64), hh = vtr(vb + (kb + 8) * VT_PITCH + db * 64);
            const bf16x8 vf = __builtin_shufflevector(lo, hh, 0, 1, 2, 3, 4, 5, 6, 7);
            if (db == 0) o0 = MFMA32(vf, pf, o0); else o1 = MFMA32(vf, pf, o1);
        }
    }
}
__device__ __forceinline__ void qk_tile64(f32x16& p0, f32x16& p1, const bf16* ksrc, int ld, const bf16x8 (&qf)[4], int lane) {
    const int r32 = lane & 31, hi = lane >> 5;
    p0 = (f32x16){}; p1 = (f32x16){};
#pragma unroll
    for (int ds = 0; ds < 4; ++ds) {
        const bf16x8 k0 = *(const GAS bf16x8*)(ksrc + (size_t)r32 * ld + ds * 16 + hi * 8);
        const bf16x8 k1 = *(const GAS bf16x8*)(ksrc + (size_t)(32 + r32) * ld + ds * 16 + hi * 8);
        p0 = MFMA32(k0, qf[ds], p0); p1 = MFMA32(k1, qf[ds], p1);
    }
}
__device__ __forceinline__ void store_ot(bf16* dst  , int ld, const f32x16& o0, const f32x16& o1, int lane) {
    const int r32 = lane & 31, hi = lane >> 5;
    bf16* rowp = dst + (size_t)r32 * ld + 4 * hi;
#pragma unroll
    for (int db = 0; db < 2; ++db)
#pragma unroll
        for (int g = 0; g < 4; ++g) { const f32x16& o = db ? o1 : o0; v2u w; w.x = pk2(o[4 * g], o[4 * g + 1]); w.y = pk2(o[4 * g + 2], o[4 * g + 3]); *(GAS v2u*)(rowp + 32 * db + 8 * g) = w; }
}

__device__ __forceinline__ void sb_half(f32x16& p, float& R, bool diag, int kbase, int qrel, int hi) {
    f32x16 L;
#pragma unroll
    for (int i = 0; i < 16; ++i) {
        const float z = p[i] * 0.125f;
        const float sp = fmaxf(z, 0.f) + LN2 * __builtin_amdgcn_logf(1.0f + __builtin_amdgcn_exp2f(-fabsf(z) * LOG2E));
        const bool msk = diag && (kbase + crow(i, hi) >= qrel);
        L[i] = msk ? 0.f : -sp;
        p[i] = msk ? -1e30f : (z - sp);
    }
    float a[4], bp[4], T[4];
#pragma unroll
    for (int m = 0; m < 4; ++m) a[m] = (L[4 * m] + L[4 * m + 1]) + (L[4 * m + 2] + L[4 * m + 3]);
#pragma unroll
    for (int m = 0; m < 4; ++m) bp[m] = __shfl_xor(a[m], 32);
    T[3] = 0.f;
#pragma unroll
    for (int m = 2; m >= 0; --m) T[m] = T[m + 1] + (a[m + 1] + bp[m + 1]);
    const float tot = T[0] + (a[0] + bp[0]);
#pragma unroll
    for (int m = 0; m < 4; ++m) {
        const float base = R + T[m] + (hi == 0 ? bp[m] : 0.f);
        const float e3 = L[4 * m + 3], e2 = L[4 * m + 2], e1 = L[4 * m + 1];
        const float b3 = base, b2 = base + e3, b1 = b2 + e2, b0 = b1 + e1;
        p[4 * m] = __builtin_amdgcn_exp2f((p[4 * m] + b0) * LOG2E); p[4 * m + 1] = __builtin_amdgcn_exp2f((p[4 * m + 1] + b1) * LOG2E);
        p[4 * m + 2] = __builtin_amdgcn_exp2f((p[4 * m + 2] + b2) * LOG2E); p[4 * m + 3] = __builtin_amdgcn_exp2f((p[4 * m + 3] + b3) * LOG2E);
    }
    R += tot;
}

__device__ __forceinline__ void mixer_unit(Frame& F, int unit) {
    const int b = unit >> 7, c = unit & 127, lane = F.lane, w = F.wave, r32 = lane & 31, hi = lane >> 5;
    LAS unsigned char* vt = F.lds + RING_OFF + w * VT_BYTES;
    LAS float* biasl = (LAS float*)(F.lds + RING_OFF + A_BIAS_OFF) + w * 260;
    LAS float* ssq = (LAS float*)(F.lds + RING_OFF + A_SSQ_OFF);
    const size_t tok0 = (size_t)b * SEQ + (size_t)c * CHUNK;
    const bf16* qkv_b = F.QKV + (size_t)b * SEQ * NQKV;
    for (int i = lane; i < NREL; i += 64) biasl[i] = F.rel_bias[w * NREL + i];
    LDS_WAIT();
#ifndef NO_GA
    for (int qb = 0; qb < 2; ++qb) {
        const bf16* qrow = F.QKV + (tok0 + qb * 32 + r32) * NQKV + w * 64;
        bf16x8 qf[4];
#pragma unroll
        for (int ds = 0; ds < 4; ++ds) qf[ds] = *(const GAS bf16x8*)(qrow + ds * 16 + hi * 8);
        float mrun = -1e30f, lrun = 0.f; f32x16 o0 = {}, o1 = {};
        const int qpos = c * CHUNK + qb * 32 + r32;
        for (int kc = (c > LEFT ? c - LEFT : 0); kc <= c; ++kc) {
            const bf16* krow = qkv_b + (size_t)kc * CHUNK * NQKV + 512 + w * 64;
            v4u vtmp[8]; load_v_tile(vtmp, krow + 512, NQKV, lane);
            f32x16 p0, p1; qk_tile64(p0, p1, krow, NQKV, qf, lane);
            write_v_tile(vt, vtmp, lane);
            const float bconst = biasl[256];
            float mx = -1e30f;
#pragma unroll
            for (int i = 0; i < 16; ++i) {
                float b0 = bconst, b1 = bconst;
                if (kc + 3 > c) { const int kp = kc * CHUNK + crow(i, hi); int r0 = qpos - kp, r1 = r0 - 32; r0 = r0 < -128 ? -128 : (r0 > 128 ? 128 : r0); r1 = r1 < -128 ? -128 : (r1 > 128 ? 128 : r1); b0 = biasl[r0 + 128]; b1 = biasl[r1 + 128]; }
                p0[i] = (p0[i] * 0.125f + b0) * LOG2E; p1[i] = (p1[i] * 0.125f + b1) * LOG2E;
                mx = fmaxf(mx, fmaxf(p0[i], p1[i]));
            }
            mx = fmaxf(mx, __shfl_xor(mx, 32));
            const float mnew = fmaxf(mrun, mx), sc = __builtin_amdgcn_exp2f(mrun - mnew);
            float ls = 0.f;
#pragma unroll
            for (int i = 0; i < 16; ++i) { p0[i] = __builtin_amdgcn_exp2f(p0[i] - mnew); p1[i] = __builtin_amdgcn_exp2f(p1[i] - mnew); ls += p0[i] + p1[i]; }
            lrun = lrun * sc + ls; mrun = mnew;
#pragma unroll
            for (int i = 0; i < 16; ++i) { o0[i] *= sc; o1[i] *= sc; }
            pv_tile64(o0, o1, p0, p1, vt, lane);
        }
        lrun += __shfl_xor(lrun, 32);
        const float il = 1.0f / lrun; float sq = 0.f;
#pragma unroll
        for (int i = 0; i < 16; ++i) { o0[i] *= il; o1[i] *= il; sq += o0[i] * o0[i] + o1[i] * o1[i]; }
        sq += __shfl_xor(sq, 32);
        if (hi == 0) ssq[(0 * 8 + w) * 64 + qb * 32 + r32] = sq;
        store_ot(F.MIXN + (tok0 + qb * 32) * D + w * 64, D, o0, o1, lane);
    }
#endif
#ifndef NO_GB
    for (int qb = 0; qb < 2; ++qb) {
        const bf16* qrow = F.QKV + (tok0 + qb * 32 + r32) * NQKV + 1536 + w * 64;
        bf16x8 qf[4];
#pragma unroll
        for (int ds = 0; ds < 4; ++ds) qf[ds] = *(const GAS bf16x8*)(qrow + ds * 16 + hi * 8);
        float R = 0.f; f32x16 o0 = {}, o1 = {};
        const int qrel = qb * 32 + r32;
        for (int kt = c; kt >= 0; --kt) {
            const bf16* krow = qkv_b + (size_t)kt * CHUNK * NQKV + 2048 + w * 64;
            v4u vtmp[8]; load_v_tile(vtmp, krow + 512, NQKV, lane);
            f32x16 p0, p1; qk_tile64(p0, p1, krow, NQKV, qf, lane);
            write_v_tile(vt, vtmp, lane);
            const bool diag = (kt == c);
            sb_half(p1, R, diag, 32, qrel, hi);
            sb_half(p0, R, diag, 0, qrel, hi);
            pv_tile64(o0, o1, p0, p1, vt, lane);
#if SB_EXIT
            if (__all(R < -SB_EXIT_T)) break;
#endif
        }
        float sq = 0.f;
#pragma unroll
        for (int i = 0; i < 16; ++i) sq += o0[i] * o0[i] + o1[i] * o1[i];
        sq += __shfl_xor(sq, 32);
        if (hi == 0) ssq[(1 * 8 + w) * 64 + qb * 32 + r32] = sq;
        store_ot(F.MIXN + (tok0 + qb * 32) * D + 512 + w * 64, D, o0, o1, lane);
    }
#endif
    VM_WAIT(); LDS_WAIT();
    __syncthreads();
    for (int qb = 0; qb < 2; ++qb) {
        float sa = 0.f, sb = 0.f;
#pragma unroll
        for (int h = 0; h < 8; ++h) { sa += ssq[(0 * 8 + h) * 64 + qb * 32 + r32]; sb += ssq[(1 * 8 + h) * 64 + qb * 32 + r32]; }
        const float ra = 1.0f / sqrtf(sa * (1.0f / 512.0f) + RMS_EPS), rb = 1.0f / sqrtf(sb * (1.0f / 512.0f) + RMS_EPS);
#pragma unroll
        for (int grp = 0; grp < 2; ++grp) { const float rs = grp ? rb : ra;
            bf16* rowp = F.MIXN + (tok0 + qb * 32 + r32) * D + grp * 512 + w * 64 + 4 * hi;
#pragma unroll
            for (int j = 0; j < 8; ++j) { GAS v2u* p = (GAS v2u*)(rowp + 8 * j); const v2u v = *p; v2u o;
                o.x = pk2(bf2f((unsigned short)(v.x & 0xffffu)) * rs, bf2f((unsigned short)(v.x >> 16)) * rs); o.y = pk2(bf2f((unsigned short)(v.y & 0xffffu)) * rs, bf2f((unsigned short)(v.y >> 16)) * rs); *p = o; } }
    }
    VM_WAIT();
    __syncthreads();
}

__device__ __forceinline__ void xattn_unit(Frame& F, int unit) {
    const int b = unit >> 7, hm = (unit >> 5) & 3, qblk = unit & 31, lane = F.lane, w = F.wave, r32 = lane & 31, hi = lane >> 5;
    LAS unsigned char* vt = F.lds + RING_OFF;
    const size_t tok0 = (size_t)b * SEQ + (size_t)qblk * 256 + w * 32;
    const bf16* qrow = F.QM + (tok0 + r32) * D + hm * HDM;
    const bf16* kvb = F.KVM + (size_t)b * MEMLEN * (2 * D) + hm * HDM;
    float mrun = -1e30f, lrun = 0.f;
    f32x16 o[8];
#pragma unroll
    for (int i = 0; i < 8; ++i) o[i] = (f32x16){};
    const int i16 = lane & 15, q4 = i16 >> 2, p4 = i16 & 3, blk = (lane >> 4) & 1;
    LAS const unsigned char* vb = vt + (4 * hi + q4) * XV_PITCH + (16 * blk + 4 * p4) * 2;
    for (int kt = 0; kt < 4; ++kt) {
        __syncthreads();
        { v4u t[4];
#pragma unroll
          for (int i = 0; i < 4; ++i) { const int p = F.tid + 512 * i, key = p >> 5, seg = p & 31; t[i] = *(const GAS v4u*)(kvb + D + (size_t)(kt * 64 + key) * (2 * D) + seg * 8); }
#pragma unroll
          for (int i = 0; i < 4; ++i) { const int p = F.tid + 512 * i, key = p >> 5, seg = p & 31; *(LAS v4u*)(vt + key * XV_PITCH + seg * 16) = t[i]; } }
        f32x16 p0 = {}, p1 = {};
        const bf16* krow = kvb + (size_t)(kt * 64) * (2 * D);
#pragma unroll 4
        for (int ds = 0; ds < 16; ++ds) {
            const bf16x8 qf = *(const GAS bf16x8*)(qrow + ds * 16 + hi * 8);
            const bf16x8 k0 = *(const GAS bf16x8*)(krow + (size_t)r32 * (2 * D) + ds * 16 + hi * 8);
            const bf16x8 k1 = *(const GAS bf16x8*)(krow + (size_t)(32 + r32) * (2 * D) + ds * 16 + hi * 8);
            p0 = MFMA32(k0, qf, p0); p1 = MFMA32(k1, qf, p1);
        }
        float mx = -1e30f;
#pragma unroll
        for (int i = 0; i < 16; ++i) { p0[i] *= 0.0625f * LOG2E; p1[i] *= 0.0625f * LOG2E; mx = fmaxf(mx, fmaxf(p0[i], p1[i])); }
        mx = fmaxf(mx, __shfl_xor(mx, 32));
        const float mnew = fmaxf(mrun, mx), sc = __builtin_amdgcn_exp2f(mrun - mnew);
        float ls = 0.f;
#pragma unroll
        for (int i = 0; i < 16; ++i) { p0[i] = __builtin_amdgcn_exp2f(p0[i] - mnew); p1[i] = __builtin_amdgcn_exp2f(p1[i] - mnew); ls += p0[i] + p1[i]; }
        lrun = lrun * sc + ls; mrun = mnew;
#pragma unroll
        for (int d = 0; d < 8; ++d)
#pragma unroll
            for (int i = 0; i < 16; ++i) o[d][i] *= sc;
        LDS_WAIT();
        __syncthreads();
#pragma unroll
        for (int ks = 0; ks < 4; ++ks) {
            const bf16x8 pf = pack8((ks >> 1) ? p1 : p0, ks & 1);
            const int kb = 32 * (ks >> 1) + 16 * (ks & 1);
#pragma unroll
            for (int db = 0; db < 8; ++db) {
                const s16x4 lo = vtr(vb + kb * XV_PITCH + db * 64), hh = vtr(vb + (kb + 8) * XV_PITCH + db * 64);
                const bf16x8 vf = __builtin_shufflevector(lo, hh, 0, 1, 2, 3, 4, 5, 6, 7);
                o[db] = MFMA32(vf, pf, o[db]);
            }
        }
    }
    lrun += __shfl_xor(lrun, 32);
    const float il = 1.0f / lrun;
    bf16* rowp = F.OM + (tok0 + r32) * D + hm * HDM + 4 * hi;
#pragma unroll
    for (int db = 0; db < 8; ++db)
#pragma unroll
        for (int g = 0; g < 4; ++g) { v2u wv; wv.x = pk2(o[db][4 * g] * il, o[db][4 * g + 1] * il); wv.y = pk2(o[db][4 * g + 2] * il, o[db][4 * g + 3] * il); *(GAS v2u*)(rowp + 32 * db + 8 * g) = wv; }
    __syncthreads();
}

__device__ __forceinline__ void ln_row(const float* yrow, const float* g, const float* bb, int lane, f32x4 (&v)[4]) {
    const GAS f32x4* yr = (const GAS f32x4*)yrow + lane;
    float s = 0.f;
#pragma unroll
    for (int j = 0; j < 4; ++j) { v[j] = yr[64 * j]; s += (v[j].x + v[j].y) + (v[j].z + v[j].w); }
    const float mean = wave_sum(s) * (1.f / D); float s2 = 0.f;
#pragma unroll
    for (int j = 0; j < 4; ++j) { v[j] = v[j] - mean; s2 += (v[j].x * v[j].x + v[j].y * v[j].y) + (v[j].z * v[j].z + v[j].w * v[j].w); }
    const float rstd = 1.f / sqrtf(wave_sum(s2) * (1.f / D) + LN_EPS);
#pragma unroll
    for (int j = 0; j < 4; ++j) { const f32x4 gg = ((const GAS f32x4*)g)[lane + 64 * j], b4 = ((const GAS f32x4*)bb)[lane + 64 * j]; v[j] = v[j] * rstd * gg + b4; }
}
__device__ __forceinline__ void store_row_f32_bf16(float* xf, bf16* xb, const f32x4 (&v)[4], int lane) {
#pragma unroll
    for (int j = 0; j < 4; ++j) { if (xf) ((GAS f32x4*)xf)[lane + 64 * j] = v[j]; v2u w; w.x = pk2(v[j].x, v[j].y); w.y = pk2(v[j].z, v[j].w); ((GAS v2u*)xb)[lane + 64 * j] = w; }
}
__device__ __forceinline__ void p8_router(Frame& F) {
    LAS float* lgp = (LAS float*)(F.lds + RING_OFF);
    LAS int* tk_e = (LAS int*)(F.lds + P8_TK_OFF); LAS float* tk_g = (LAS float*)(F.lds + P8_TK_OFF + 1024); LAS int* tk_p = (LAS int*)(F.lds + P8_TK_OFF + 2048);
    LAS int* hist = (LAS int*)(F.lds + P8_TK_OFF + 3072); LAS int* basee = hist + 32;
    if (F.tid < 32) hist[F.tid] = 0;
    LDS_WAIT(); __syncthreads();
    const int lane = F.lane, w = F.wave, r32 = lane & 31, hi = lane >> 5;
    const float* g = F.ln_g + D, *bb = F.ln_b + D;
    for (int tile = F.vcu; tile < M / 64; tile += F.G) {
        const int row0 = tile * 64;
        for (int rr = 0; rr < 8; ++rr) { const int ra = row0 + w * 8 + rr; f32x4 va[4]; ln_row(F.Y + (size_t)ra * D, g, bb, lane, va); store_row_f32_bf16(F.X2 + (size_t)ra * D, F.X2B + (size_t)ra * D, va, lane); }
        VM_WAIT(); __syncthreads();
        { const int tb = w & 1, kq = w >> 1;
          const float* xrow = F.X2 + (size_t)(row0 + tb * 32 + r32) * D + kq * 256 + hi * 8;
          const bf16* wh = F.WRH + (size_t)r32 * D + kq * 256 + hi * 8; const bf16* wlo = F.WRL + (size_t)r32 * D + kq * 256 + hi * 8;
          f32x16 acc = {};
#pragma unroll 4
          for (int s2 = 0; s2 < 16; ++s2) {
              const f32x4 xa = *(const GAS f32x4*)(xrow + s2 * 16), xb = *(const GAS f32x4*)(xrow + s2 * 16 + 4);
              v4u ph, pl;
              ph.x = pk2(xa.x, xa.y); ph.y = pk2(xa.z, xa.w); ph.z = pk2(xb.x, xb.y); ph.w = pk2(xb.z, xb.w);
              pl.x = pk2(xa.x - bf2f((unsigned short)(ph.x & 0xffffu)), xa.y - bf2f((unsigned short)(ph.x >> 16))); pl.y = pk2(xa.z - bf2f((unsigned short)(ph.y & 0xffffu)), xa.w - bf2f((unsigned short)(ph.y >> 16)));
              pl.z = pk2(xb.x - bf2f((unsigned short)(ph.z & 0xffffu)), xb.y - bf2f((unsigned short)(ph.z >> 16))); pl.w = pk2(xb.z - bf2f((unsigned short)(ph.w & 0xffffu)), xb.w - bf2f((unsigned short)(ph.w >> 16)));
              const bf16x8 xh = __builtin_bit_cast(bf16x8, ph), xl = __builtin_bit_cast(bf16x8, pl);
              const bf16x8 ah = *(const GAS bf16x8*)(wh + s2 * 16), al = *(const GAS bf16x8*)(wlo + s2 * 16);
              acc = MFMA32(ah, xh, acc); acc = MFMA32(al, xh, acc); acc = MFMA32(ah, xl, acc);
          }
#pragma unroll
          for (int i = 0; i < 16; ++i) lgp[(kq * 64 + tb * 32 + r32) * 33 + crow(i, hi)] = acc[i];
        }
        LDS_WAIT(); __syncthreads();
        if (F.tid < 64) {
            const int r = F.tid; float l[32];
#pragma unroll
            for (int e = 0; e < 32; ++e) l[e] = ((lgp[r * 33 + e] + lgp[(64 + r) * 33 + e]) + (lgp[(128 + r) * 33 + e] + lgp[(192 + r) * 33 + e])) + F.b_router[e];
            int idx[4]; float val[4]; unsigned taken = 0u;
#pragma unroll
            for (int k = 0; k < 4; ++k) { float best = -3.0e38f; int bi = 0;
#pragma unroll
                for (int e = 0; e < 32; ++e) { const bool ok = !((taken >> e) & 1u) && (l[e] > best); best = ok ? l[e] : best; bi = ok ? e : bi; }
                idx[k] = bi; val[k] = best; taken |= 1u << bi; }
            float ex[4], sm = 0.f;
#pragma unroll
            for (int k = 0; k < 4; ++k) { ex[k] = __expf(val[k] - val[0]); sm += ex[k]; }
            const float is = 1.0f / sm;
#pragma unroll
            for (int k = 0; k < 4; ++k) { tk_e[r * 4 + k] = idx[k]; tk_g[r * 4 + k] = ex[k] * is; tk_p[r * 4 + k] = __hip_atomic_fetch_add(hist + idx[k], 1, __ATOMIC_RELAXED, __HIP_MEMORY_SCOPE_WORKGROUP); }
        }
        LDS_WAIT(); __syncthreads();
        if (F.tid < 32) { const int h = hist[F.tid]; int bs = 0; if (h > 0) bs = (int)__hip_atomic_fetch_add((unsigned*)(F.ctl + CW_CNT + 64 * F.tid), (unsigned)h, RLX_AGENT); basee[F.tid] = bs; hist[F.tid] = 0; }
        LDS_WAIT(); __syncthreads();
        if (F.tid < 256) { const int r = F.tid >> 2, k = F.tid & 3, e = tk_e[r * 4 + k], pos = basee[e] + tk_p[r * 4 + k];
            if (pos < CAP) { F.LSLOT[e * CAP + pos] = (row0 + r) * 4 + k; F.LGATE[e * CAP + pos] = tk_g[r * 4 + k]; } }
        LDS_WAIT(); __syncthreads();
    }
}
__device__ __forceinline__ int build_group_table(Frame& F) {
    LAS int* tab = (LAS int*)(F.lds + TAB_OFF);
    __syncthreads();
    if (F.tid < 32) { int c = (int)__hip_atomic_load((unsigned*)(F.ctl + CW_CNT + 64 * F.tid), RLX_AGENT); c = c > CAP ? CAP : c; tab[64 + F.tid] = c; }
    LDS_WAIT(); __syncthreads();
    if (F.tid == 0) { int p = 0; for (int e = 0; e < 32; ++e) { tab[e] = p; p += (tab[64 + e] + 255) >> 8; } tab[32] = p; }
    LDS_WAIT(); __syncthreads();
    return __builtin_amdgcn_readfirstlane(tab[32]);
}
__device__ __forceinline__ void p11_combine(Frame& F) {
    const int gw = F.vcu * NWAVES + F.wave, NGW = F.G * NWAVES, lane = F.lane;
    const float* g = F.ln_g + 2 * D, *bb = F.ln_b + 2 * D;
    for (int m = gw; m < M; m += NGW) {
        const GAS f32x4* xr = (const GAS f32x4*)(F.X2 + (size_t)m * D) + lane;
        f32x4 v[4]; float s = 0.f;
#pragma unroll
        for (int j = 0; j < 4; ++j) { f32x4 a = xr[64 * j] * ALPHA;
#pragma unroll
            for (int k = 0; k < 4; ++k) { const v2u y = ((const GAS v2u*)(F.YS + ((size_t)m * 4 + k) * D))[lane + 64 * j];
                a.x += bf2f((unsigned short)(y.x & 0xffffu)); a.y += bf2f((unsigned short)(y.x >> 16)); a.z += bf2f((unsigned short)(y.y & 0xffffu)); a.w += bf2f((unsigned short)(y.y >> 16)); }
            v[j] = a; s += (a.x + a.y) + (a.z + a.w); }
        const float mean = wave_sum(s) * (1.f / D); float s2 = 0.f;
#pragma unroll
        for (int j = 0; j < 4; ++j) { v[j] = v[j] - mean; s2 += (v[j].x * v[j].x + v[j].y * v[j].y) + (v[j].z * v[j].z + v[j].w * v[j].w); }
        const float rstd = 1.f / sqrtf(wave_sum(s2) * (1.f / D) + LN_EPS);
#pragma unroll
        for (int j = 0; j < 4; ++j) { const f32x4 gg = ((const GAS f32x4*)g)[lane + 64 * j], b4 = ((const GAS f32x4*)bb)[lane + 64 * j]; ((GAS f32x4*)(F.out + (size_t)m * D))[lane + 64 * j] = v[j] * rstd * gg + b4; }
    }
}

struct Args { const float* in[18]; float* out; unsigned char* ws; int ph_lo, ph_hi; };
__global__ void __launch_bounds__(NWAVES * 64, 2) trunk_fwd(Args args) {
    extern __shared__ __attribute__((aligned(16))) unsigned char lds[];
    Frame F;
    F.lds = (LAS unsigned char*)lds;
    F.MISC = (volatile LAS unsigned*)(F.lds + MISC_OFF);
    F.tid = threadIdx.x; F.lane = F.tid & 63; F.wave = __builtin_amdgcn_readfirstlane(F.tid >> 6);
    F.G = gridDim.x; { const int bx = blockIdx.x; F.vcu = (F.G % 8 == 0) ? (bx % 8) * (F.G / 8) + bx / 8 : bx; }
    unsigned char* ws = args.ws;
    F.ctl = (gu32*)(ws + WS_CTL);
    F.x = args.in[0]; F.mem = args.in[1]; F.w_in = args.in[2]; F.rel_bias = args.in[3]; F.g_a = args.in[4]; F.g_b = args.in[5]; F.w_out = args.in[6]; F.w_q = args.in[7]; F.w_kv = args.in[8];
    F.w_o = args.in[9]; F.w_router = args.in[10]; F.b_router = args.in[11]; F.w_gu = args.in[12]; F.b_gu = args.in[13]; F.w_down = args.in[14]; F.b_down = args.in[15]; F.ln_g = args.in[16]; F.ln_b = args.in[17];
    F.out = args.out;
    F.Win_t = (bf16*)(ws + WS_WIN); F.Wout_t = (bf16*)(ws + WS_WOUT); F.Wq_t = (bf16*)(ws + WS_WQ); F.Wkv_t = (bf16*)(ws + WS_WKV); F.Wo_t = (bf16*)(ws + WS_WO); F.Wgu_t = (bf16*)(ws + WS_WGU); F.Wd_t = (bf16*)(ws + WS_WD); F.WRH = (bf16*)(ws + WS_WRH); F.WRL = (bf16*)(ws + WS_WRL);
    F.XB = (bf16*)(ws + WS_XB); F.MEMB = (bf16*)(ws + WS_MEMB); F.KVM = (bf16*)(ws + WS_KVM); F.QKV = (bf16*)(ws + WS_QKV); F.MIXN = (bf16*)(ws + WS_MIXN); F.X1B = (bf16*)(ws + WS_X1B);
    F.QM = (bf16*)(ws + WS_QM); F.OM = (bf16*)(ws + WS_OM); F.X2B = (bf16*)(ws + WS_X2B); F.H = (bf16*)(ws + WS_H); F.YS = (bf16*)(ws + WS_YS);
    F.Y = (float*)(ws + WS_Y); F.X1 = (float*)(ws + WS_X1); F.X2 = (float*)(ws + WS_X2); F.LGATE = (float*)(ws + WS_LGATE); F.LSLOT = (int*)(ws + WS_LSLOT);
    for (int u = F.tid; u < (LDS_BYTES - LDSCTL_OFF) / 4; u += NWAVES * 64) ((LAS unsigned*)(F.lds + LDSCTL_OFF))[u] = 0u;
    __syncthreads();
    XcdBarrier bar; bar.bar = (unsigned*)(F.ctl + CW_BAR); bar.x = 0; bar.st = nullptr;
    if (N_LAUNCHES != PER_PHASE) bar = xcd_barrier_post((unsigned*)(F.ctl + CW_BAR), F.MISC + 8);
#define GRID_BAR() do { if (N_LAUNCHES != PER_PHASE) xcd_barrier(bar); } while (0)
    const int lo = args.ph_lo, hi = args.ph_hi;
#ifndef PH_MASK
#define PH_MASK 0xFFF
#endif
#define IN(k) (lo <= (k) && (k) < hi && ((PH_MASK >> (k)) & 1))
#define BOTH(k) (IN(k) && IN((k) + 1))

    if (IN(0)) { p0_prologue(F); if (BOTH(0)) GRID_BAR(); }
    if (IN(1)) {
        pg8::Gemm g{F.XB, F.Win_t, M, NQKV, D, nullptr}; pg8::StaticOrder S; S.init(M, NQKV, F.G, (int)blockIdx.x);
        pg8::EpiBf16 E{F.QKV, NQKV};
        pg8::gemm_phase<pg8::EpiBf16, pg8::StaticOrder, false, true>(F.lds + RING_OFF, g, S, E);
        if (BOTH(1)) GRID_BAR();
    }
    if (IN(2)) {
        for (int u = F.vcu; u < BATCH * (SEQ / CHUNK); u += F.G) mixer_unit(F, u);
        if (BOTH(2)) GRID_BAR();
    }
    if (IN(3)) {
        pg8::Gemm g{F.MIXN, F.Wout_t, M, D, D, nullptr}; pg8::StaticOrder S; S.init(M, D, F.G, (int)blockIdx.x);
        pg8::EpiResF32 E{F.Y, F.x, D, ALPHA};
        pg8::gemm_phase<pg8::EpiResF32, pg8::StaticOrder, false, false>(F.lds + RING_OFF, g, S, E);
        if (BOTH(3)) GRID_BAR();
    }
    if (IN(4)) {
        if (F.vcu < 16) {
            pg8::Gemm g{F.MEMB, F.Wkv_t, MEMROWS, 2 * D, D, nullptr}; pg8::StaticOrder S; S.init(MEMROWS, 2 * D, 16, F.vcu);
            pg8::EpiBf16 E{F.KVM, 2 * D};
            pg8::gemm_phase<pg8::EpiBf16, pg8::StaticOrder, false, false>(F.lds + RING_OFF, g, S, E);
        }
        const int gw = F.vcu * NWAVES + F.wave, NGW = F.G * NWAVES;
        for (int m = gw; m < M; m += NGW) { f32x4 v[4]; ln_row(F.Y + (size_t)m * D, F.ln_g, F.ln_b, F.lane, v); store_row_f32_bf16(F.X1 + (size_t)m * D, F.X1B + (size_t)m * D, v, F.lane); }
        if (BOTH(4)) GRID_BAR();
    }
    if (IN(5)) {
        pg8::Gemm g{F.X1B, F.Wq_t, M, D, D, nullptr}; pg8::StaticOrder S; S.init(M, D, F.G, (int)blockIdx.x);
        pg8::EpiBf16 E{F.QM, D};
        pg8::gemm_phase<pg8::EpiBf16, pg8::StaticOrder, false, false>(F.lds + RING_OFF, g, S, E);
        if (BOTH(5)) GRID_BAR();
    }
    if (IN(6)) {
        for (int u = F.vcu; u < BATCH * 4 * (SEQ / 256); u += F.G) xattn_unit(F, u);
        if (BOTH(6)) GRID_BAR();
    }
    if (IN(7)) {
        pg8::Gemm g{F.OM, F.Wo_t, M, D, D, nullptr}; pg8::StaticOrder S; S.init(M, D, F.G, (int)blockIdx.x);
        pg8::EpiResF32 E{F.Y, F.X1, D, ALPHA};
        pg8::gemm_phase<pg8::EpiResF32, pg8::StaticOrder, false, false>(F.lds + RING_OFF, g, S, E);
        if (BOTH(7)) GRID_BAR();
    }
    if (IN(8)) { p8_router(F); if (BOTH(8)) GRID_BAR(); }
    if (IN(9)) {
        const int ntile = build_group_table(F);
        pg8::Gemm g{F.X2B, F.Wgu_t, 0, 2 * DFF, D, F.LSLOT};
        pg8::GroupOrder S{(const LAS int*)(F.lds + TAB_OFF), 2 * DFF / 256, ntile * (2 * DFF / 256), F.G, F.vcu, (size_t)2 * DFF * D * 2};
        pg8::EpiSwiglu E{F.H, F.b_gu};
        pg8::gemm_phase<pg8::EpiSwiglu, pg8::GroupOrder, true, true>(F.lds + RING_OFF, g, S, E);
        if (BOTH(9)) GRID_BAR();
    }
    if (IN(10)) {
        const int ntile = build_group_table(F);
        pg8::Gemm g{F.H, F.Wd_t, 0, D, DFF, nullptr};
        pg8::GroupOrder S{(const LAS int*)(F.lds + TAB_OFF), D / 256, ntile * (D / 256), F.G, F.vcu, (size_t)D * DFF * 2};
        pg8::EpiDown E{F.YS, F.b_down, F.LSLOT, F.LGATE};
        pg8::gemm_phase<pg8::EpiDown, pg8::GroupOrder, false, true>(F.lds + RING_OFF, g, S, E);
        if (BOTH(10)) GRID_BAR();
    }
    if (IN(11)) { p11_combine(F); }
#undef IN
#undef BOTH
}

extern "C" void kernel_launch(void* const* d_in, const int* in_sizes, int n_in, void* d_out, int out_size, void* d_ws, size_t ws_size, hipStream_t stream) {
    static int grid = 0;
    if (grid == 0) {
        if (n_in != 18 || in_sizes[0] != M * D || out_size != M * D || ws_size < WS_END) { fprintf(stderr, "kernel_launch: unexpected shapes (n_in %d, in0 %d, out %d, ws %zu); nothing launched\n", n_in, n_in > 0 ? in_sizes[0] : -1, out_size, ws_size); grid = -1; return; }
        int dev = 0, cus = 0, per_cu = 0;
        if (hipGetDevice(&dev) != hipSuccess || hipDeviceGetAttribute(&cus, hipDeviceAttributeMultiprocessorCount, dev) != hipSuccess) { grid = -1; return; }
        if (hipFuncSetAttribute((const void*)trunk_fwd, hipFuncAttributeMaxDynamicSharedMemorySize, LDS_BYTES) != hipSuccess) { fprintf(stderr, "kernel_launch: hipFuncSetAttribute failed\n"); grid = -1; return; }
        if (hipOccupancyMaxActiveBlocksPerMultiprocessor(&per_cu, (const void*)trunk_fwd, NWAVES * 64, LDS_BYTES) != hipSuccess || per_cu < 1)
            fprintf(stderr, "kernel_launch: note: occupancy query reports %d workgroups per CU\n", per_cu);
        (void)hipGetLastError();
        grid = cus;
    }
    if (grid < 0) return;
    if (hipMemsetAsync((char*)d_ws + WS_CTL, 0, CTL_ZERO_BYTES, stream) != hipSuccess) return;
    Args a{};
    for (int i = 0; i < 18; ++i) a.in[i] = (const float*)d_in[i];
    a.out = (float*)d_out; a.ws = (unsigned char*)d_ws;
    if (N_LAUNCHES == 1) { a.ph_lo = 0; a.ph_hi = PER_PHASE; hipLaunchKernelGGL(trunk_fwd, dim3(grid), dim3(NWAVES * 64), LDS_BYTES, stream, a); }
    else for (int li = 0; li < PER_PHASE; ++li) { a.ph_lo = li; a.ph_hi = li + 1; hipLaunchKernelGGL(trunk_fwd, dim3(grid), dim3(NWAVES * 64), LDS_BYTES, stream, a); }
}
```

```cpp
#include <hip/hip_runtime.h>
#include <cstdio>
#include <cstdint>

#define GAS __attribute__((address_space(1)))
#define LAS __attribute__((address_space(3)))
typedef unsigned short bf16;
typedef unsigned v4u __attribute__((ext_vector_type(4)));
typedef unsigned v2u __attribute__((ext_vector_type(2)));
typedef float f32x4 __attribute__((ext_vector_type(4)));
typedef float f32x2 __attribute__((ext_vector_type(2)));
typedef float f32x16 __attribute__((ext_vector_type(16)));
typedef short bf16x8 __attribute__((ext_vector_type(8)));
typedef short s16x4 __attribute__((ext_vector_type(4)));
typedef __bf16 bf16x2_t __attribute__((ext_vector_type(2)));

constexpr int BATCH = 2, SEQ = 8192, D = 1024, M = BATCH * SEQ;
constexpr int NQKV = 3072, CHUNK = 64, LEFT = 8, NREL = 257;
constexpr int MEMLEN = 256, MEMROWS = BATCH * MEMLEN, HDM = 256;
constexpr int NEXP = 32, TOPK = 4, DFF = 1024, CAP = 16384;
constexpr int HROWS = M * TOPK + NEXP * 256;
constexpr float LN_EPS = 1e-5f, RMS_EPS = 1e-6f;
constexpr float ALPHA = 1.189207115002721f;
constexpr float LOG2E = 1.4426950408889634f, LN2 = 0.6931471805599453f;
#ifndef SB_EXIT
#define SB_EXIT 1
#endif
constexpr float SB_EXIT_T = 104.0f;

namespace pg8 {
constexpr int BM = 256, BK = 64, HALF = 128, HTB = HALF * BK * 2, STAGE_BYTES = 8 * HTB, NXCD = 8, WGM = 8;
__host__ __device__ __forceinline__ int lds_byte(int r, int c) { const int st = (r >> 4) * 2 + (c >> 5), rr = r & 15, cc = c & 31, ob = rr * 64 + cc * 2; return st * 1024 + (ob ^ (((ob >> 9) & 1) << 5)); }
__host__ __device__ __forceinline__ void stage_rc(int b, int& R, int& C) { const int st = b / 1024, sb = b % 1024, swz = sb ^ (((sb >> 9) & 1) << 5); R = (st >> 1) * 16 + swz / 64; C = (st & 1) * 32 + (swz % 64) / 2; }
__host__ __device__ __forceinline__ int perm32(int rho) { const int n = rho >> 4, i = rho & 15; return 8 * (i >> 2) + 4 * n + (i & 3); }

struct Unit { int pm, pn, e, lrow, cnt, pad; size_t boff, aoff, coff; };
struct Gemm { const bf16* A; const bf16* Bt; int M, N, K; const int* lst; int lda, ldb; };

struct StaticOrder {
    int nM, nN, nwg, G, c;
    __device__ void init(int M_, int N_, int G_, int c_) { nM = M_ / BM; nN = N_ / BM; nwg = nM * nN; G = G_; c = c_; }
    __device__ bool next(int i, Unit& u) const {
        const long L = (long)i * G + c; if (L >= nwg) return false;
        int wgid = (int)L; { const int q = nwg / NXCD, r = nwg % NXCD, xcd = wgid % NXCD, off = wgid / NXCD; wgid = (xcd < r ? xcd * (q + 1) : r * (q + 1) + (xcd - r) * q) + off; }
        const int nig = WGM * nN, gid = wgid / nig, fm = gid * WGM, gsz = (nM - fm) < WGM ? (nM - fm) : WGM;
        u.pm = fm + ((wgid % nig) % gsz); u.pn = (wgid % nig) / gsz; u.e = 0; u.lrow = 0; u.cnt = 256; u.pad = 0; u.boff = 0; u.aoff = 0; u.coff = 0; return true;
    }
};
struct GroupOrder {
    const LAS int* tab; int npn, total, G, c; size_t bstride;
    __device__ bool next(int i, Unit& u) const {
        const int U = i * G + c; if (U >= total) return false;
        int e = 0; while (e < NEXP - 1 && __builtin_amdgcn_readfirstlane(tab[e + 1]) * npn <= U) ++e;
        const int t0 = __builtin_amdgcn_readfirstlane(tab[e]), t1 = __builtin_amdgcn_readfirstlane(tab[e + 1]), ce = __builtin_amdgcn_readfirstlane(tab[64 + e]);
        const int idx = U - t0 * npn, Te = t1 - t0, lt = idx % Te, pn = idx / Te;
        u.pm = t0 + lt; u.pn = pn; u.e = e; u.lrow = e * CAP + lt * 256; const int rem = ce - lt * 256; u.cnt = rem < 256 ? rem : 256; u.pad = 0; u.boff = (size_t)e * bstride; u.aoff = 0; u.coff = 0; return true;
    }
};

struct BatchOrder : StaticOrder { size_t bbatch;
    __device__ bool next(int i, Unit& u) const { if (!StaticOrder::next(i, u)) return false; u.boff = (u.pm >= 32) ? bbatch : 0; return true; } };
struct MiniOrder { int which, idx;
    __device__ bool next(int i, Unit& u) const {
        if (i != 0 || idx < 0) return false;
        const int prob = idx >> 2, t = idx & 3, b = prob >> 2, h = prob & 3;
        u.e = 0; u.lrow = 0; u.cnt = 256; u.pad = 0;
        if (which == 0) { u.pm = 0; u.pn = t; u.aoff = ((size_t)(b * 256) * 2048 + h * 256) * 2; u.boff = (size_t)(h * 256) * 2; u.coff = (size_t)b * 1024 * 1024 + (size_t)(h * 256) * 1024; }
        else            { u.pm = t; u.pn = 0; u.aoff = (size_t)(h * 256) * 2; u.boff = ((size_t)(b * 256) * 2048 + 1024 + h * 256) * 2; u.coff = (size_t)b * 1024 * 1024 + h * 256; }
        return true; } };

__device__ __forceinline__ unsigned cvt_pk_bf16(float lo, float hi) { f32x2 v = {lo, hi}; bf16x2_t b = __builtin_convertvector(v, bf16x2_t); return __builtin_bit_cast(unsigned, b); }

struct EpiBf16 {
    static constexpr bool PERM = true;
    bf16* O; int ldc;
    __device__ __forceinline__ void operator()(const f32x4 (&acc)[2][2][4][2], const Unit& u, int wr, int wc, int fr, int fq) const {
        const int row0 = u.pm * BM + wr * 64 + fr, col0 = u.pn * BM + wc * 32 + 8 * fq;
#pragma unroll
        for (int ai = 0; ai < 2; ++ai)
#pragma unroll
            for (int m = 0; m < 4; ++m) { bf16* rowp = O + (size_t)(row0 + ai * HALF + m * 16) * ldc + col0;
#pragma unroll
                for (int bj = 0; bj < 2; ++bj) { const f32x4 v0 = acc[ai][bj][m][0], v1 = acc[ai][bj][m][1];
                    v4u w; w.x = cvt_pk_bf16(v0[0], v0[1]); w.y = cvt_pk_bf16(v0[2], v0[3]); w.z = cvt_pk_bf16(v1[0], v1[1]); w.w = cvt_pk_bf16(v1[2], v1[3]);
                    *(v4u*)(rowp + bj * HALF) = w; } }
    }
};
struct EpiScaleBf16C {
    static constexpr bool PERM = true;
    bf16* O; int ldc; float scale;
    __device__ __forceinline__ void operator()(const f32x4 (&acc)[2][2][4][2], const Unit& u, int wr, int wc, int fr, int fq) const {
        const int row0 = u.pm * BM + wr * 64 + fr, col0 = u.pn * BM + wc * 32 + 8 * fq;
#pragma unroll
        for (int ai = 0; ai < 2; ++ai)
#pragma unroll
            for (int m = 0; m < 4; ++m) { bf16* rowp = O + u.coff + (size_t)(row0 + ai * HALF + m * 16) * ldc + col0;
#pragma unroll
                for (int bj = 0; bj < 2; ++bj) { const f32x4 v0 = acc[ai][bj][m][0] * scale, v1 = acc[ai][bj][m][1] * scale;
                    v4u w; w.x = cvt_pk_bf16(v0[0], v0[1]); w.y = cvt_pk_bf16(v0[2], v0[3]); w.z = cvt_pk_bf16(v1[0], v1[1]); w.w = cvt_pk_bf16(v1[2], v1[3]);
                    *(v4u*)(rowp + bj * HALF) = w; } }
    }
};
struct EpiSoftmax {
    static constexpr bool PERM = true;
    bf16* P; int ldc; LAS f32x2* xch;
    __device__ __forceinline__ void operator()(f32x4 (&acc)[2][2][4][2], const Unit& u, int wr, int wc, int fr, int fq) const {
        float ml[2][4];
#pragma unroll
        for (int ai = 0; ai < 2; ++ai)
#pragma unroll
            for (int m = 0; m < 4; ++m) {
                float mx = -3.0e38f;
#pragma unroll
                for (int bj = 0; bj < 2; ++bj)
#pragma unroll
                    for (int n = 0; n < 2; ++n) { const f32x4 v = acc[ai][bj][m][n]; mx = fmaxf(mx, fmaxf(fmaxf(v[0], v[1]), fmaxf(v[2], v[3]))); }
                mx = fmaxf(mx, __shfl_xor(mx, 16)); mx = fmaxf(mx, __shfl_xor(mx, 32));
                float sm = 0.f;
#pragma unroll
                for (int bj = 0; bj < 2; ++bj)
#pragma unroll
                    for (int n = 0; n < 2; ++n) { f32x4 v = acc[ai][bj][m][n];
                        v[0] = __builtin_amdgcn_exp2f(v[0] - mx); v[1] = __builtin_amdgcn_exp2f(v[1] - mx); v[2] = __builtin_amdgcn_exp2f(v[2] - mx); v[3] = __builtin_amdgcn_exp2f(v[3] - mx);
                        sm += (v[0] + v[1]) + (v[2] + v[3]); acc[ai][bj][m][n] = v; }
                sm += __shfl_xor(sm, 16); sm += __shfl_xor(sm, 32);
                ml[ai][m] = mx;
                if (fq == 0) xch[(ai * HALF + wr * 64 + m * 16 + fr) * 4 + wc] = (f32x2){mx, sm};
            }
        asm volatile("s_waitcnt lgkmcnt(0)" ::: "memory"); __builtin_amdgcn_s_barrier(); asm volatile("" ::: "memory");
        const int row0 = u.pm * BM + wr * 64 + fr, col0 = u.pn * BM + wc * 32 + 8 * fq;
#pragma unroll
        for (int ai = 0; ai < 2; ++ai)
#pragma unroll
            for (int m = 0; m < 4; ++m) {
                const LAS f32x2* xr = xch + (ai * HALF + wr * 64 + m * 16 + fr) * 4;
                const f32x2 a = xr[0], b = xr[1], c = xr[2], d = xr[3];
                const float mg = fmaxf(fmaxf(a.x, b.x), fmaxf(c.x, d.x));
                const float tot = (a.y * __builtin_amdgcn_exp2f(a.x - mg) + b.y * __builtin_amdgcn_exp2f(b.x - mg)) + (c.y * __builtin_amdgcn_exp2f(c.x - mg) + d.y * __builtin_amdgcn_exp2f(d.x - mg));
                const float f = __builtin_amdgcn_exp2f(ml[ai][m] - mg) / tot;
                bf16* rowp = P + (size_t)(row0 + ai * HALF + m * 16) * ldc + col0;
#pragma unroll
                for (int bj = 0; bj < 2; ++bj) { const f32x4 v0 = acc[ai][bj][m][0] * f, v1 = acc[ai][bj][m][1] * f;
                    v4u w; w.x = cvt_pk_bf16(v0[0], v0[1]); w.y = cvt_pk_bf16(v0[2], v0[3]); w.z = cvt_pk_bf16(v1[0], v1[1]); w.w = cvt_pk_bf16(v1[2], v1[3]);
                    *(v4u*)(rowp + bj * HALF) = w; } }
    }
};
struct EpiResF32 {
    static constexpr bool PERM = false;
    float* C; const float* res; int ldc; float alpha;
    __device__ __forceinline__ void operator()(const f32x4 (&acc)[2][2][4][2], const Unit& u, int wr, int wc, int fr, int fq) const {
        const int row0 = u.pm * BM + wr * 64 + fr, col0 = u.pn * BM + wc * 32 + 4 * fq;
#pragma unroll
        for (int ai = 0; ai < 2; ++ai)
#pragma unroll
            for (int m = 0; m < 4; ++m) { const size_t off = (size_t)(row0 + ai * HALF + m * 16) * ldc + col0;
#pragma unroll
                for (int bj = 0; bj < 2; ++bj)
#pragma unroll
                    for (int n = 0; n < 2; ++n) { const f32x4 r = *(const f32x4*)(res + off + bj * HALF + n * 16); *(f32x4*)(C + off + bj * HALF + n * 16) = r * alpha + acc[ai][bj][m][n]; } }
    }
};
struct EpiSwiglu {
    static constexpr bool PERM = true;
    bf16* H; const float* bias;
    __device__ __forceinline__ void operator()(const f32x4 (&acc)[2][2][4][2], const Unit& u, int wr, int wc, int fr, int fq) const {
        const int row0 = u.pm * BM + wr * 64 + fr, cc = u.pn * HALF + wc * 32 + 8 * fq;
        const float* bg = bias + (size_t)u.e * (2 * DFF) + cc; const float* bu = bg + DFF;
        f32x4 bgv[2], buv[2];
#pragma unroll
        for (int n = 0; n < 2; ++n) { bgv[n] = *(const f32x4*)(bg + 4 * n); buv[n] = *(const f32x4*)(bu + 4 * n); }
#pragma unroll
        for (int ai = 0; ai < 2; ++ai)
#pragma unroll
            for (int m = 0; m < 4; ++m) { float o[8];
#pragma unroll
                for (int n = 0; n < 2; ++n)
#pragma unroll
                    for (int j = 0; j < 4; ++j) { float g = acc[ai][0][m][n][j] + bgv[n][j], up = acc[ai][1][m][n][j] + buv[n][j];
                        g = fminf(g, 7.0f); up = fminf(fmaxf(up, -7.0f), 7.0f);
                        const float glu = g * __builtin_amdgcn_rcpf(1.0f + __builtin_amdgcn_exp2f(-1.702f * LOG2E * g));
                        o[4 * n + j] = (up + 1.0f) * glu; }
                v4u w; w.x = cvt_pk_bf16(o[0], o[1]); w.y = cvt_pk_bf16(o[2], o[3]); w.z = cvt_pk_bf16(o[4], o[5]); w.w = cvt_pk_bf16(o[6], o[7]);
                *(v4u*)(H + (size_t)(row0 + ai * HALF + m * 16) * DFF + cc) = w; }
    }
};
struct EpiDown {
    static constexpr bool PERM = true;
    bf16* YS; const float* bias; const int* lslot; const float* lgate;
    __device__ __forceinline__ void operator()(const f32x4 (&acc)[2][2][4][2], const Unit& u, int wr, int wc, int fr, int fq) const {
        const int col0 = u.pn * BM + wc * 32 + 8 * fq;
        f32x4 bv[2][2];
#pragma unroll
        for (int bj = 0; bj < 2; ++bj)
#pragma unroll
            for (int n = 0; n < 2; ++n) bv[bj][n] = *(const f32x4*)(bias + (size_t)u.e * D + col0 + bj * HALF + 4 * n);
#pragma unroll
        for (int ai = 0; ai < 2; ++ai)
#pragma unroll
            for (int m = 0; m < 4; ++m) { const int r = ai * HALF + wr * 64 + m * 16 + fr;
                if (r < u.cnt) { const int slot = lslot[u.lrow + r]; const float gt = lgate[u.lrow + r]; bf16* rowp = YS + (size_t)slot * D + col0;
#pragma unroll
                    for (int bj = 0; bj < 2; ++bj) { const f32x4 v0 = (acc[ai][bj][m][0] + bv[bj][0]) * gt, v1 = (acc[ai][bj][m][1] + bv[bj][1]) * gt;
                        v4u w; w.x = cvt_pk_bf16(v0[0], v0[1]); w.y = cvt_pk_bf16(v0[2], v0[3]); w.z = cvt_pk_bf16(v1[0], v1[1]); w.w = cvt_pk_bf16(v1[2], v1[3]);
                        *(v4u*)(rowp + bj * HALF) = w; } } }
    }
};

template <class Epi, class Sched, bool GATHER, bool ALIGN_EPI>
__device__ __forceinline__ void gemm_phase(LAS unsigned char* lds, const Gemm g, const Sched& S, const Epi& E) {
    const int tid = threadIdx.x, wid = __builtin_amdgcn_readfirstlane(tid >> 6), lane = tid & 63, wr = wid >> 2, wc = wid & 3, fr = lane & 15, fq = lane >> 4;
    const int K = g.K, nt = K / BK;
    unsigned voffB[2]; int RA[2]; unsigned CA2[2];
#pragma unroll
    for (int i = 0; i < 2; ++i) { int R, C; stage_rc(tid * 16 + i * 8192, R, C); const int Rb = Epi::PERM ? ((R & ~31) + perm32(R & 31)) : R;
        voffB[i] = (unsigned)(Rb * g.ldb + C) * 2u; RA[i] = R; CA2[i] = (unsigned)C * 2u; }
    const size_t kstep = (size_t)(BK * 2);
    const size_t hstepA = (size_t)HALF * g.lda * 2, hstep = (size_t)HALF * g.ldb * 2;
    const size_t tstepA = 2 * hstepA, tstep = 2 * hstep;
    const unsigned ldsw = (unsigned)wid * 1024u;
    const int aoff = lds_byte(wr * 64 + fr, fq * 8), boff = lds_byte(wc * 32 + fr, fq * 8);
#define PG8_SA(b, h) (((b) * 2 + (h)) * HTB)
#define PG8_SB(b, h) ((4 + (b) * 2 + (h)) * HTB)
#define PG8_STAGE_B(bufoff, gbase) do { _Pragma("unroll") for (int _i = 0; _i < 2; ++_i) \
        __builtin_amdgcn_global_load_lds((const unsigned*)((const char*)(gbase) + voffB[_i]), (LAS unsigned*)(lds + (bufoff) + ldsw + _i * 8192), 16, 0, 0); } while (0)
#define PG8_STAGE_A(bufoff, gbase, AO, h) do { _Pragma("unroll") for (int _i = 0; _i < 2; ++_i) \
        __builtin_amdgcn_global_load_lds((const unsigned*)((const char*)(gbase) + AO[h][_i]), (LAS unsigned*)(lds + (bufoff) + ldsw + _i * 8192), 16, 0, 0); } while (0)
#define PG8_SETA(AO, U) do { _Pragma("unroll") for (int _h = 0; _h < 2; ++_h) _Pragma("unroll") for (int _i = 0; _i < 2; ++_i) { \
        if (GATHER) { const int _rr = _h * HALF + RA[_i]; int _tok = 0; if (_rr < (U).cnt) _tok = g.lst[(U).lrow + _rr] >> 2; AO[_h][_i] = (unsigned)_tok * (unsigned)(g.lda * 2) + CA2[_i]; } \
        else AO[_h][_i] = (unsigned)(_h * (int)hstepA) + (unsigned)(RA[_i] * g.lda * 2) + CA2[_i]; } } while (0)
#define PG8_LDA(dst, b, h) do { _Pragma("unroll") for (int m = 0; m < 4; ++m) _Pragma("unroll") for (int k = 0; k < 2; ++k) dst[m][k] = *(const LAS bf16x8*)(lds + PG8_SA(b, h) + aoff + m * 2048 + k * 1024); } while (0)
#define PG8_LDB(dst, b, h) do { _Pragma("unroll") for (int n = 0; n < 2; ++n) _Pragma("unroll") for (int k = 0; k < 2; ++k) dst[n][k] = *(const LAS bf16x8*)(lds + PG8_SB(b, h) + boff + n * 2048 + k * 1024); } while (0)
#define PG8_MMA(ai, bj, At, Bt) do { __builtin_amdgcn_s_setprio(1); _Pragma("unroll") for (int m = 0; m < 4; ++m) _Pragma("unroll") for (int n = 0; n < 2; ++n) _Pragma("unroll") for (int k = 0; k < 2; ++k) \
        acc[ai][bj][m][n] = __builtin_amdgcn_mfma_f32_16x16x32_bf16(Bt[n][k], At[m][k], acc[ai][bj][m][n], 0, 0, 0); __builtin_amdgcn_s_setprio(0); } while (0)
#define PG8_WAIT_V(n) asm volatile("s_waitcnt vmcnt(" #n ")" ::: "memory")
#define PG8_WAIT_L(n) asm volatile("s_waitcnt lgkmcnt(" #n ")" ::: "memory")
#define PG8_BAR __builtin_amdgcn_s_barrier()
#define PG8_SCHED __builtin_amdgcn_sched_barrier(0)
    Unit cur, nxt; int ui = 0;
    if (!S.next(0, cur)) return;
    f32x4 acc[2][2][4][2];
#pragma unroll
    for (int a = 0; a < 2; ++a)
#pragma unroll
        for (int b = 0; b < 2; ++b)
#pragma unroll
            for (int m = 0; m < 4; ++m)
#pragma unroll
                for (int n = 0; n < 2; ++n) acc[a][b][m][n] = (f32x4){0.f, 0.f, 0.f, 0.f};
    bf16x8 At[4][2], B0[2][2], B1[2][2];
    unsigned aC[2][2], aN[2][2];
    PG8_SETA(aC, cur);
    const char* cA = GATHER ? (const char*)g.A : (const char*)g.A + cur.aoff + (size_t)cur.pm * tstepA;
    const char* cB = (const char*)g.Bt + cur.boff + (size_t)cur.pn * tstep;
    PG8_STAGE_B(PG8_SB(0, 0), cB); PG8_STAGE_B(PG8_SB(0, 1), cB + hstep); PG8_STAGE_A(PG8_SA(0, 0), cA, aC, 0); PG8_STAGE_A(PG8_SA(0, 1), cA, aC, 1);
    if (wr == 1) PG8_BAR;
    PG8_WAIT_V(2); PG8_BAR;
    PG8_STAGE_B(PG8_SB(1, 0), cB + kstep); PG8_STAGE_A(PG8_SA(1, 0), cA + kstep, aC, 0); PG8_STAGE_B(PG8_SB(1, 1), cB + hstep + kstep);
    PG8_WAIT_V(6); PG8_BAR;
    for (;;) {
        const bool has_next = S.next(ui + 1, nxt);
        const char* nA = cA; const char* nB = cB;
        if (has_next) { nA = GATHER ? (const char*)g.A : (const char*)g.A + nxt.aoff + (size_t)nxt.pm * tstepA; nB = (const char*)g.Bt + nxt.boff + (size_t)nxt.pn * tstep; PG8_SETA(aN, nxt); }
        else {
#pragma unroll
            for (int h = 0; h < 2; ++h)
#pragma unroll
                for (int i = 0; i < 2; ++i) aN[h][i] = aC[h][i]; }
        for (int t = 0; t < nt; t += 2) {
            const bool last = (t == nt - 2);
            const char* a1 = cA + (size_t)(t + 1) * kstep;
            const char* a2 = last ? nA : cA + (size_t)(t + 2) * kstep; const char* b2 = last ? nB : cB + (size_t)(t + 2) * kstep;
            const char* a3 = a2 + kstep; const char* b3 = b2 + kstep;
            unsigned aX[2][2];
#pragma unroll
            for (int h = 0; h < 2; ++h)
#pragma unroll
                for (int i = 0; i < 2; ++i) aX[h][i] = (GATHER && last) ? aN[h][i] : aC[h][i];
            PG8_LDB(B0, 0, 0); PG8_LDB(B1, 0, 1); PG8_SCHED; PG8_LDA(At, 0, 0); PG8_STAGE_A(PG8_SA(1, 1), a1, aC, 1);
            PG8_WAIT_V(8); PG8_WAIT_L(0); PG8_BAR; PG8_MMA(0, 0, At, B0); PG8_MMA(0, 1, At, B1); PG8_BAR; PG8_SCHED;
            PG8_LDA(At, 0, 1); PG8_STAGE_B(PG8_SB(0, 0), b2); PG8_STAGE_B(PG8_SB(0, 1), b2 + hstep); PG8_STAGE_A(PG8_SA(0, 0), a2, aX, 0);
            PG8_WAIT_V(8); PG8_WAIT_L(0); PG8_BAR; PG8_MMA(1, 0, At, B0); PG8_MMA(1, 1, At, B1); PG8_BAR; PG8_SCHED;
            PG8_LDB(B0, 1, 0); PG8_LDB(B1, 1, 1); PG8_SCHED; PG8_LDA(At, 1, 0); PG8_STAGE_A(PG8_SA(0, 1), a2, aX, 1);
            PG8_WAIT_V(8); PG8_WAIT_L(0); PG8_BAR; PG8_MMA(0, 0, At, B0); PG8_MMA(0, 1, At, B1); PG8_BAR; PG8_SCHED;
            PG8_LDA(At, 1, 1); PG8_STAGE_B(PG8_SB(1, 0), b3); PG8_STAGE_B(PG8_SB(1, 1), b3 + hstep); PG8_STAGE_A(PG8_SA(1, 0), a3, aX, 0);
            PG8_WAIT_V(8); PG8_WAIT_L(0); PG8_BAR; PG8_MMA(1, 0, At, B0); PG8_MMA(1, 1, At, B1); PG8_BAR; PG8_SCHED;
        }
        if constexpr (ALIGN_EPI) { if (wr == 0) PG8_BAR; }
        E(acc, cur, wr, wc, fr, fq);
        if (!has_next) break;
#pragma unroll
        for (int a = 0; a < 2; ++a)
#pragma unroll
            for (int b = 0; b < 2; ++b)
#pragma unroll
                for (int m = 0; m < 4; ++m)
#pragma unroll
                    for (int n = 0; n < 2; ++n) acc[a][b][m][n] = (f32x4){0.f, 0.f, 0.f, 0.f};
        cur = nxt; cA = nA; cB = nB; ++ui;
#pragma unroll
        for (int h = 0; h < 2; ++h)
#pragma unroll
            for (int i = 0; i < 2; ++i) aC[h][i] = aN[h][i];
        if constexpr (ALIGN_EPI) { if (wr == 1) PG8_BAR; }
    }
    PG8_WAIT_V(0);
    if constexpr (!ALIGN_EPI) { if (wr == 0) PG8_BAR; }
    PG8_BAR;
#undef PG8_SA
#undef PG8_SB
#undef PG8_STAGE_A
#undef PG8_STAGE_B
#undef PG8_SETA
#undef PG8_LDA
#undef PG8_LDB
#undef PG8_MMA
#undef PG8_WAIT_V
#undef PG8_WAIT_L
#undef PG8_BAR
#undef PG8_SCHED
}
}

constexpr int NWAVES = 8;
#ifndef MK_N_LAUNCHES
#define MK_N_LAUNCHES 1
#endif
constexpr int PER_PHASE = 12;
constexpr int N_LAUNCHES = MK_N_LAUNCHES;

constexpr size_t MiB = 1u << 20;
constexpr size_t WS_CTL = 0, CTL_ZERO_BYTES = 1 * MiB;
constexpr size_t WS_WIN = 2 * MiB, WS_WOUT = 8 * MiB, WS_WQ = 10 * MiB, WS_WKV = 12 * MiB, WS_WO = 16 * MiB;
constexpr size_t WS_MEMB = 18 * MiB, WS_KVM = 19 * MiB, WS_LSLOT = 21 * MiB, WS_LGATE = 23 * MiB, WS_WRH = 25 * MiB, WS_WRL = 25 * MiB + 65536;
constexpr size_t WS_WGU = 32 * MiB, WS_WD = 160 * MiB;
constexpr size_t WS_XB = 224 * MiB, WS_QKV = 256 * MiB, WS_MIXN = 352 * MiB, WS_Y = 384 * MiB, WS_X1 = 448 * MiB, WS_X1B = 512 * MiB;
constexpr size_t WS_QM = 544 * MiB, WS_OM = 576 * MiB, WS_X2 = 608 * MiB, WS_X2B = 672 * MiB, WS_VWT = 704 * MiB, WS_END = 708 * MiB;
constexpr size_t WS_WKT = 26 * MiB;
constexpr size_t WS_H = 224 * MiB;
constexpr size_t WS_YS = 384 * MiB;
static_assert(WS_H + (size_t)HROWS * DFF * 2 <= WS_Y && WS_YS + (size_t)M * TOPK * D * 2 <= WS_X1B, "overlay map");
constexpr int CW_TMO = 0, CW_BAR = 4096, CW_CNT = 8192;

constexpr int RING_OFF = 0, RING_BYTES = 131072;
constexpr int LDSCTL_OFF = RING_BYTES, MISC_OFF = LDSCTL_OFF + 320;
constexpr int TAB_OFF = LDSCTL_OFF + 512;
constexpr int P8_TK_OFF = LDSCTL_OFF + 1024;
constexpr int XCH_OFF = LDSCTL_OFF + 6144;
constexpr int LDS_BYTES = 147456;
static_assert(XCH_OFF + 8192 <= LDS_BYTES, "LDS map");
static_assert(P8_TK_OFF + 3 * 1024 + 256 <= LDS_BYTES && 4 * 64 * 33 * 4 <= RING_BYTES, "LDS map");
constexpr int VT_PITCH = 144, VT_BYTES = 64 * VT_PITCH;
constexpr int A_BIAS_OFF = 8 * VT_BYTES;
constexpr int A_SSQ_OFF = A_BIAS_OFF + 8 * 260 * 4;
static_assert(A_SSQ_OFF + 2 * 8 * 64 * 4 <= RING_BYTES, "mixer LDS");
constexpr int XV_PITCH = 528, XV_BYTES = 64 * XV_PITCH;

typedef GAS unsigned gu32;
#define RLX_AGENT __ATOMIC_RELAXED, __HIP_MEMORY_SCOPE_AGENT
#define LDS_WAIT() asm volatile("s_waitcnt lgkmcnt(0)" ::: "memory")
#define VM_WAIT() asm volatile("s_waitcnt vmcnt(0)" ::: "memory")
__device__ __forceinline__ unsigned pk2(float lo, float hi) { return pg8::cvt_pk_bf16(lo, hi); }
__device__ __forceinline__ float bf2f(unsigned short h) { return __uint_as_float(((unsigned)h) << 16); }
#define MFMA32(a, b, c) __builtin_amdgcn_mfma_f32_32x32x16_bf16((a), (b), (c), 0, 0, 0)
__device__ __forceinline__ int crow(int reg, int h) { return (reg & 3) + 8 * (reg >> 2) + 4 * h; }
__device__ __forceinline__ s16x4 vtr(LAS const unsigned char* p) { return __builtin_bit_cast(s16x4, __builtin_amdgcn_ds_read_tr16_b64_v4i16((LAS s16x4*)p)); }
__device__ __forceinline__ bf16x8 pack8(const f32x16& x, int s) {
    v4u p; p.x = pk2(x[8 * s], x[8 * s + 1]); p.y = pk2(x[8 * s + 2], x[8 * s + 3]); p.z = pk2(x[8 * s + 4], x[8 * s + 5]); p.w = pk2(x[8 * s + 6], x[8 * s + 7]);
    return __builtin_bit_cast(bf16x8, p);
}

#define XB_TMO      128
#define XB_XCNT(j)  (256  + 64 * (j))
#define XB_XSUB(j)  (1280 + 64 * (j))
#define XB_XGEN(j)  (2304 + 64 * (j))
#define XB_TOP      3328
#define XB_TOPGEN   3392
#define XCD_BAR_WORDS 3456
#define XB_SPIN_CAP (1u << 18)
__device__ __forceinline__ unsigned xb_ld(unsigned* p)              { return __hip_atomic_load(p, __ATOMIC_RELAXED, __HIP_MEMORY_SCOPE_AGENT); }
__device__ __forceinline__ unsigned xb_add(unsigned* p, unsigned v) { return __hip_atomic_fetch_add(p, v, __ATOMIC_RELAXED, __HIP_MEMORY_SCOPE_AGENT); }
__device__ __forceinline__ unsigned xb_xcc_id() { return (unsigned)__builtin_amdgcn_s_getreg((3 << 11) | 20) & 0xFu; }
#define XB_SPIN(cond, bar) do { unsigned _sp = 0; while (cond) { __builtin_amdgcn_s_sleep(1); \
    if ((++_sp & 255u) == 0u) { if (xb_ld(&(bar)[XB_TMO])) break; if (_sp > XB_SPIN_CAP) { atomicAdd(&(bar)[XB_TMO], 1u); break; } } } } while (0)
struct XcdBarrier { unsigned* bar; unsigned x; volatile LAS unsigned* st; };
__device__ __forceinline__ XcdBarrier xcd_barrier_post(unsigned* bar, volatile LAS unsigned* st) {
    XcdBarrier b; b.bar = bar; b.x = xb_xcc_id(); b.st = st;
    if (threadIdx.x == 0) (void)xb_add(&bar[XB_XCNT(b.x)], 1u);
    return b;
}
__device__ __forceinline__ void xcd_barrier_complete(unsigned* bar, unsigned x, unsigned& nloc, unsigned& nx) {
    const unsigned G = gridDim.x * gridDim.y * gridDim.z;
    unsigned sum, cnt, mine, sp = 0u;
    for (;;) {
        sum = 0u; cnt = 0u; mine = 0u;
#pragma unroll
        for (unsigned j = 0; j < 16; ++j) { const unsigned c = xb_ld(&bar[XB_XCNT(j)]); sum += c; cnt += (c > 0u) ? 1u : 0u; mine = (j == x) ? c : mine; }
        if (sum == G) break;
        __builtin_amdgcn_s_sleep(1);
        if ((++sp & 255u) == 0u) { if (xb_ld(&bar[XB_TMO])) break; if (sp > XB_SPIN_CAP) { atomicAdd(&bar[XB_TMO], 1u); break; } }
    }
    nloc = mine > 0u ? mine : 1u; nx = cnt > 0u ? cnt : 1u;
}
__device__ __forceinline__ void xcd_barrier(const XcdBarrier& b) {
    asm volatile("s_waitcnt vmcnt(0)" ::: "memory");
    __syncthreads();
    if (threadIdx.x == 0) {
        unsigned* bar = b.bar;
        __builtin_amdgcn_s_waitcnt(0);
        unsigned nloc = b.st[0], nx = b.st[1];
        if (nloc == 0u) { xcd_barrier_complete(bar, b.x, nloc, nx); b.st[0] = nloc; b.st[1] = nx; }
        const unsigned old = xb_add(&bar[XB_XSUB(b.x)], 1u);
        const unsigned gen = old / nloc;
        if (old + 1u == (gen + 1u) * nloc) {
            __builtin_amdgcn_fence(__ATOMIC_RELEASE, "agent");
            asm volatile("s_waitcnt vmcnt(0)" ::: "memory");
            const unsigned og = xb_add(&bar[XB_TOP], 1u);
            const unsigned tg = og / nx;
            if (og + 1u == (tg + 1u) * nx) xb_add(&bar[XB_TOPGEN], 1u);
            else XB_SPIN(xb_ld(&bar[XB_TOPGEN]) == tg, bar);
            __builtin_amdgcn_fence(__ATOMIC_ACQUIRE, "agent");
            xb_add(&bar[XB_XGEN(b.x)], 1u);
            asm volatile("s_waitcnt vmcnt(0)" ::: "memory");
        } else {
            XB_SPIN(xb_ld(&bar[XB_XGEN(b.x)]) == gen, bar);
            __builtin_amdgcn_fence(__ATOMIC_ACQUIRE, "agent");
            asm volatile("s_waitcnt vmcnt(0)" ::: "memory");
        }
    }
    __syncthreads();
}

struct Frame {
    LAS unsigned char* lds;
    volatile LAS unsigned* MISC;
    gu32* ctl;
    int tid, lane, wave;
    int vcu, G;
    const float *x, *mem, *w_in, *rel_bias, *g_a, *g_b, *w_out, *w_q, *w_kv, *w_o, *w_router, *b_router, *w_gu, *b_gu, *w_down, *b_down, *ln_g, *ln_b;
    float* out;
    bf16 *Win_t, *Wout_t, *Wq_n, *Wkv_t, *Wo_t, *Wgu_t, *Wd_t, *WRH, *WRL, *WKT, *VWT, *PB;
    bf16 *XB, *MEMB, *KVM, *QKV, *MIXN, *X1B, *QM, *OM, *X2B, *H, *YS;
    float *Y, *X1, *X2, *LGATE;
    int* LSLOT;
};

__device__ __forceinline__ float wave_sum(float v) {
#pragma unroll
    for (int o = 1; o < 64; o <<= 1) v += __shfl_xor(v, o);
    return v;
}

template <int RM>
__device__ __forceinline__ void p0_transpose_item(const float* W, int K, int N, bf16* WT, const float* ksc, LAS float* scr, int item, int lane) {
    const int nblk = N / 32, kb = item / nblk, nb = item % nblk, k0 = 64 * kb, n0 = 32 * nb;
#pragma unroll 8
    for (int i = 0; i < 32; ++i) { const int kk = 2 * i + (lane >> 5); float v = W[(size_t)(k0 + kk) * N + n0 + (lane & 31)]; if (ksc) v *= ksc[k0 + kk]; scr[kk * 33 + (lane & 31)] = v; }
    LDS_WAIT(); asm volatile("" ::: "memory");
    const int c = lane & 7;
    int d0 = n0;
    if (RM == 1) { const int t = n0 >> 10, rem = n0 & 1023, p = rem >> 7, j = rem & 127; d0 = 256 * p + 128 * t + j; }
#pragma unroll
    for (int j = 0; j < 4; ++j) { const int n = (lane >> 3) + 8 * j; const LAS float* s = scr + (8 * c) * 33 + n;
        v4u o; o.x = pk2(s[0 * 33], s[1 * 33]); o.y = pk2(s[2 * 33], s[3 * 33]); o.z = pk2(s[4 * 33], s[5 * 33]); o.w = pk2(s[6 * 33], s[7 * 33]);
        *(GAS v4u*)(WT + (size_t)(d0 + n) * K + k0 + 8 * c) = o; }
    LDS_WAIT(); asm volatile("" ::: "memory");
}
__device__ __forceinline__ void row_to_bf16(const float* xrow, bf16* orow, int lane) {
    const GAS f32x4* xr = (const GAS f32x4*)xrow + lane;
    GAS v2u* o8 = (GAS v2u*)orow + lane;
#pragma unroll
    for (int j = 0; j < 4; ++j) { const f32x4 v = xr[64 * j]; v2u w; w.x = pk2(v.x, v.y); w.y = pk2(v.z, v.w); o8[64 * j] = w; }
}
__device__ __forceinline__ void p0_prologue(Frame& F) {
    LAS float* scr = (LAS float*)(F.lds + RING_OFF + F.wave * 16384);
    const int gw = F.vcu * NWAVES + F.wave, NGW = F.G * NWAVES;
    constexpr int I_IN = (D / 64) * (NQKV / 32), I_SQ = (D / 64) * (D / 32), I_KV = (D / 64) * (2 * D / 32), I_GU = (D / 64) * (2 * DFF / 32), I_DN = (DFF / 64) * (D / 32);
    constexpr int NITEMS = I_IN + 2 * I_SQ + I_KV + NEXP * (I_GU + I_DN);
    for (int it = gw; it < NITEMS; it += NGW) {
        int r = it;
        if (r < I_IN) { p0_transpose_item<0>(F.w_in, D, NQKV, F.Win_t, nullptr, scr, r, F.lane); continue; } r -= I_IN;
        if (r < I_SQ) { const int kb = r / (D / 32); p0_transpose_item<0>(F.w_out, D, D, F.Wout_t, kb < 8 ? F.g_a : F.g_b - 512, scr, r, F.lane); continue; } r -= I_SQ;

        if (r < I_SQ) { p0_transpose_item<0>(F.w_o, D, D, F.Wo_t, nullptr, scr, r, F.lane); continue; } r -= I_SQ;
        if (r < I_KV) { p0_transpose_item<0>(F.w_kv, D, 2 * D, F.Wkv_t, nullptr, scr, r, F.lane); continue; } r -= I_KV;
        if (r < NEXP * I_GU) { const int e = r / I_GU; p0_transpose_item<1>(F.w_gu + (size_t)e * D * 2 * DFF, D, 2 * DFF, F.Wgu_t + (size_t)e * 2 * DFF * D, nullptr, scr, r % I_GU, F.lane); continue; } r -= NEXP * I_GU;
        { const int e = r / I_DN; p0_transpose_item<0>(F.w_down + (size_t)e * DFF * D, DFF, D, F.Wd_t + (size_t)e * D * DFF, nullptr, scr, r % I_DN, F.lane); }
    }
    for (int m = gw; m < M; m += NGW) row_to_bf16(F.x + (size_t)m * D, F.XB + (size_t)m * D, F.lane);
    for (int m = gw; m < MEMROWS; m += NGW) row_to_bf16(F.mem + (size_t)m * D, F.MEMB + (size_t)m * D, F.lane);
    for (int m = gw; m < D; m += NGW) row_to_bf16(F.w_q + (size_t)m * D, F.Wq_n + (size_t)m * D, F.lane);
    for (int i = F.vcu * (NWAVES * 64) + F.tid; i < NEXP * D; i += F.G * NWAVES * 64) {
        const int e = i >> 10, k = i & 1023; const float v = F.w_router[k * NEXP + e];
        const unsigned h = pk2(v, 0.f) & 0xffffu; const float r = v - bf2f((unsigned short)h);
        F.WRH[i] = (bf16)h; F.WRL[i] = (bf16)(pk2(r, 0.f) & 0xffffu); }
}

__device__ __forceinline__ void load_v_tile(v4u (&t)[8], const bf16* vsrc  , int ld, int lane) {
#pragma unroll
    for (int i = 0; i < 8; ++i) { const int p = lane + 64 * i, key = p >> 3, seg = p & 7; t[i] = *(const GAS v4u*)(vsrc + (size_t)key * ld + seg * 8); }
}
__device__ __forceinline__ void write_v_tile(LAS unsigned char* vt, const v4u (&t)[8], int lane) {
#pragma unroll
    for (int i = 0; i < 8; ++i) { const int p = lane + 64 * i, key = p >> 3, seg = p & 7; *(LAS v4u*)(vt + key * VT_PITCH + seg * 16) = t[i]; }
    asm volatile("" ::: "memory");
}
__device__ __forceinline__ void pv_tile64(f32x16& o0, f32x16& o1, const f32x16& p0, const f32x16& p1, LAS const unsigned char* vt, int lane) {
    const int hi = lane >> 5, i16 = lane & 15, q4 = i16 >> 2, p4 = i16 & 3, blk = (lane >> 4) & 1;
    LAS const unsigned char* vb = vt + (4 * hi + q4) * VT_PITCH + (16 * blk + 4 * p4) * 2;
#pragma unroll
    for (int ks = 0; ks < 4; ++ks) {
        const bf16x8 pf = pack8((ks >> 1) ? p1 : p0, ks & 1);
        const int kb = 32 * (ks >> 1) + 16 * (ks & 1);
#pragma unroll
        for (int db = 0; db < 2; ++db) {
            const s16x4 lo = vtr(vb + kb * VT_PITCH + db * 64), hh = vtr(vb + (kb + 8) * VT_PITCH + db * 64);
            const bf16x8 vf = __builtin_shufflevector(lo, hh, 0, 1, 2, 3, 4, 5, 6, 7);
            if (db == 0) o0 = MFMA32(vf, pf, o0); else o1 = MFMA32(vf, pf, o1);
        }
    }
}
__device__ __forceinline__ void load_k_frags(bf16x8 (&kf)[8], const bf16* ksrc, int ld, int lane) {
    const int r32 = lane & 31, hi = lane >> 5;
#pragma unroll
    for (int ds = 0; ds < 4; ++ds) { kf[2 * ds] = *(const GAS bf16x8*)(ksrc + (size_t)r32 * ld + ds * 16 + hi * 8); kf[2 * ds + 1] = *(const GAS bf16x8*)(ksrc + (size_t)(32 + r32) * ld + ds * 16 + hi * 8); }
}
__device__ __forceinline__ void qk_tile64(f32x16& p0, f32x16& p1, const bf16x8 (&kf)[8], const bf16x8 (&qf)[4]) {
    p0 = (f32x16){}; p1 = (f32x16){};
#pragma unroll
    for (int ds = 0; ds < 4; ++ds) { p0 = MFMA32(kf[2 * ds], qf[ds], p0); p1 = MFMA32(kf[2 * ds + 1], qf[ds], p1); }
}
__device__ __forceinline__ void store_ot(bf16* dst  , int ld, const f32x16& o0, const f32x16& o1, int lane) {
    const int r32 = lane & 31, hi = lane >> 5;
    bf16* rowp = dst + (size_t)r32 * ld + 4 * hi;
#pragma unroll
    for (int db = 0; db < 2; ++db)
#pragma unroll
        for (int g = 0; g < 4; ++g) { const f32x16& o = db ? o1 : o0; v2u w; w.x = pk2(o[4 * g], o[4 * g + 1]); w.y = pk2(o[4 * g + 2], o[4 * g + 3]); *(GAS v2u*)(rowp + 32 * db + 8 * g) = w; }
}

__device__ __forceinline__ void sb_half(f32x16& p, float& R, bool diag, int kbase, int qrel, int hi) {
    f32x16 L;
#pragma unroll
    for (int i = 0; i < 16; ++i) {
        const float z = p[i] * 0.125f;
        const float sp = fmaxf(z, 0.f) + LN2 * __builtin_amdgcn_logf(1.0f + __builtin_amdgcn_exp2f(-fabsf(z) * LOG2E));
        const bool msk = diag && (kbase + crow(i, hi) >= qrel);
        L[i] = msk ? 0.f : -sp;
        p[i] = msk ? -1e30f : (z - sp);
    }
    float a[4], bp[4], T[4];
#pragma unroll
    for (int m = 0; m < 4; ++m) a[m] = (L[4 * m] + L[4 * m + 1]) + (L[4 * m + 2] + L[4 * m + 3]);
#pragma unroll
    for (int m = 0; m < 4; ++m) bp[m] = __shfl_xor(a[m], 32);
    T[3] = 0.f;
#pragma unroll
    for (int m = 2; m >= 0; --m) T[m] = T[m + 1] + (a[m + 1] + bp[m + 1]);
    const float tot = T[0] + (a[0] + bp[0]);
#pragma unroll
    for (int m = 0; m < 4; ++m) {
        const float base = R + T[m] + (hi == 0 ? bp[m] : 0.f);
        const float e3 = L[4 * m + 3], e2 = L[4 * m + 2], e1 = L[4 * m + 1];
        const float b3 = base, b2 = base + e3, b1 = b2 + e2, b0 = b1 + e1;
        p[4 * m] = __builtin_amdgcn_exp2f((p[4 * m] + b0) * LOG2E); p[4 * m + 1] = __builtin_amdgcn_exp2f((p[4 * m + 1] + b1) * LOG2E);
        p[4 * m + 2] = __builtin_amdgcn_exp2f((p[4 * m + 2] + b2) * LOG2E); p[4 * m + 3] = __builtin_amdgcn_exp2f((p[4 * m + 3] + b3) * LOG2E);
    }
    R += tot;
}

__device__ __forceinline__ void mixer_unit(Frame& F, int unit) {
    const int b = unit >> 7, c = unit & 127, lane = F.lane, w = F.wave, r32 = lane & 31, hi = lane >> 5;
    LAS unsigned char* vt = F.lds + RING_OFF + w * VT_BYTES;
    LAS float* biasl = (LAS float*)(F.lds + RING_OFF + A_BIAS_OFF) + w * 260;
    LAS float* ssq = (LAS float*)(F.lds + RING_OFF + A_SSQ_OFF);
    const size_t tok0 = (size_t)b * SEQ + (size_t)c * CHUNK;
    const bf16* qkv_b = F.QKV + (size_t)b * SEQ * NQKV;
    for (int i = lane; i < NREL; i += 64) biasl[i] = F.rel_bias[w * NREL + i];
    LDS_WAIT();
#ifndef NO_GA
    for (int qb = 0; qb < 2; ++qb) {
        const bf16* qrow = F.QKV + (tok0 + qb * 32 + r32) * NQKV + w * 64;
        bf16x8 qf[4];
#pragma unroll
        for (int ds = 0; ds < 4; ++ds) qf[ds] = *(const GAS bf16x8*)(qrow + ds * 16 + hi * 8);
        float mrun = -1e30f, lrun = 0.f; f32x16 o0 = {}, o1 = {};
        const int qpos = c * CHUNK + qb * 32 + r32;
        const int kc0 = (c > LEFT ? c - LEFT : 0);
        v4u vtmp[8]; bf16x8 kf[8];
        { const bf16* krow = qkv_b + (size_t)kc0 * CHUNK * NQKV + 512 + w * 64; load_k_frags(kf, krow, NQKV, lane); load_v_tile(vtmp, krow + 512, NQKV, lane); }
        for (int kc = kc0; kc <= c; ++kc) {
            f32x16 p0, p1; qk_tile64(p0, p1, kf, qf);
            write_v_tile(vt, vtmp, lane);
            const int kn = kc < c ? kc + 1 : c; const bf16* krown = qkv_b + (size_t)kn * CHUNK * NQKV + 512 + w * 64;
            load_v_tile(vtmp, krown + 512, NQKV, lane);
            const float bconst = biasl[256];
            float mx = -1e30f;
#pragma unroll
            for (int i = 0; i < 16; ++i) {
                float b0 = bconst, b1 = bconst;
                if (kc + 3 > c) { const int kp = kc * CHUNK + crow(i, hi); int r0 = qpos - kp, r1 = r0 - 32; r0 = r0 < -128 ? -128 : (r0 > 128 ? 128 : r0); r1 = r1 < -128 ? -128 : (r1 > 128 ? 128 : r1); b0 = biasl[r0 + 128]; b1 = biasl[r1 + 128]; }
                p0[i] = (p0[i] * 0.125f + b0) * LOG2E; p1[i] = (p1[i] * 0.125f + b1) * LOG2E;
                mx = fmaxf(mx, fmaxf(p0[i], p1[i]));
            }
            mx = fmaxf(mx, __shfl_xor(mx, 32));
            const float mnew = fmaxf(mrun, mx), sc = __builtin_amdgcn_exp2f(mrun - mnew);
            float ls = 0.f;
#pragma unroll
            for (int i = 0; i < 16; ++i) { p0[i] = __builtin_amdgcn_exp2f(p0[i] - mnew); p1[i] = __builtin_amdgcn_exp2f(p1[i] - mnew); ls += p0[i] + p1[i]; }
            lrun = lrun * sc + ls; mrun = mnew;
#pragma unroll
            for (int i = 0; i < 16; ++i) { o0[i] *= sc; o1[i] *= sc; }
            load_k_frags(kf, krown, NQKV, lane);
            pv_tile64(o0, o1, p0, p1, vt, lane);
        }
        lrun += __shfl_xor(lrun, 32);
        const float il = 1.0f / lrun; float sq = 0.f;
#pragma unroll
        for (int i = 0; i < 16; ++i) { o0[i] *= il; o1[i] *= il; sq += o0[i] * o0[i] + o1[i] * o1[i]; }
        sq += __shfl_xor(sq, 32);
        if (hi == 0) ssq[(0 * 8 + w) * 64 + qb * 32 + r32] = sq;
        store_ot(F.MIXN + (tok0 + qb * 32) * D + w * 64, D, o0, o1, lane);
    }
#endif
#ifndef NO_GB
    for (int qb = 0; qb < 2; ++qb) {
        const bf16* qrow = F.QKV + (tok0 + qb * 32 + r32) * NQKV + 1536 + w * 64;
        bf16x8 qf[4];
#pragma unroll
        for (int ds = 0; ds < 4; ++ds) qf[ds] = *(const GAS bf16x8*)(qrow + ds * 16 + hi * 8);
        float R = 0.f; f32x16 o0 = {}, o1 = {};
        const int qrel = qb * 32 + r32;
        v4u vtmp[8]; bf16x8 kf[8];
        { const bf16* krow = qkv_b + (size_t)c * CHUNK * NQKV + 2048 + w * 64; load_k_frags(kf, krow, NQKV, lane); load_v_tile(vtmp, krow + 512, NQKV, lane); }
        for (int kt = c; kt >= 0; --kt) {
            f32x16 p0, p1; qk_tile64(p0, p1, kf, qf);
            write_v_tile(vt, vtmp, lane);
            { const int kn = kt > 0 ? kt - 1 : 0; const bf16* krow = qkv_b + (size_t)kn * CHUNK * NQKV + 2048 + w * 64; load_k_frags(kf, krow, NQKV, lane); load_v_tile(vtmp, krow + 512, NQKV, lane); }
            const bool diag = (kt == c);
            sb_half(p1, R, diag, 32, qrel, hi);
            sb_half(p0, R, diag, 0, qrel, hi);
            pv_tile64(o0, o1, p0, p1, vt, lane);
#if SB_EXIT
            if (__all(R < -SB_EXIT_T)) break;
#endif
        }
        float sq = 0.f;
#pragma unroll
        for (int i = 0; i < 16; ++i) sq += o0[i] * o0[i] + o1[i] * o1[i];
        sq += __shfl_xor(sq, 32);
        if (hi == 0) ssq[(1 * 8 + w) * 64 + qb * 32 + r32] = sq;
        store_ot(F.MIXN + (tok0 + qb * 32) * D + 512 + w * 64, D, o0, o1, lane);
    }
#endif
    VM_WAIT(); LDS_WAIT();
    __syncthreads();
    for (int qb = 0; qb < 2; ++qb) {
        float sa = 0.f, sb = 0.f;
#pragma unroll
        for (int h = 0; h < 8; ++h) { sa += ssq[(0 * 8 + h) * 64 + qb * 32 + r32]; sb += ssq[(1 * 8 + h) * 64 + qb * 32 + r32]; }
        const float ra = 1.0f / sqrtf(sa * (1.0f / 512.0f) + RMS_EPS), rb = 1.0f / sqrtf(sb * (1.0f / 512.0f) + RMS_EPS);
#pragma unroll
        for (int grp = 0; grp < 2; ++grp) { const float rs = grp ? rb : ra;
            bf16* rowp = F.MIXN + (tok0 + qb * 32 + r32) * D + grp * 512 + w * 64 + 4 * hi;
#pragma unroll
            for (int j = 0; j < 8; ++j) { GAS v2u* p = (GAS v2u*)(rowp + 8 * j); const v2u v = *p; v2u o;
                o.x = pk2(bf2f((unsigned short)(v.x & 0xffffu)) * rs, bf2f((unsigned short)(v.x >> 16)) * rs); o.y = pk2(bf2f((unsigned short)(v.y & 0xffffu)) * rs, bf2f((unsigned short)(v.y >> 16)) * rs); *p = o; } }
    }
    VM_WAIT();
    __syncthreads();
}

__device__ __forceinline__ void xattn_unit(Frame& F, int unit) {
    const int b = unit >> 7, hm = (unit >> 5) & 3, qblk = unit & 31, lane = F.lane, w = F.wave, r32 = lane & 31, hi = lane >> 5;
    LAS unsigned char* vt = F.lds + RING_OFF;
    const size_t tok0 = (size_t)b * SEQ + (size_t)qblk * 256 + w * 32;
    const bf16* qrow = F.QM + (tok0 + r32) * D + hm * HDM;
    const bf16* kvb = F.KVM + (size_t)b * MEMLEN * (2 * D) + hm * HDM;
    float mrun = -1e30f, lrun = 0.f;
    f32x16 o[8];
#pragma unroll
    for (int i = 0; i < 8; ++i) o[i] = (f32x16){};
    const int i16 = lane & 15, q4 = i16 >> 2, p4 = i16 & 3, blk = (lane >> 4) & 1;
    LAS const unsigned char* vb = vt + (4 * hi + q4) * XV_PITCH + (16 * blk + 4 * p4) * 2;
    for (int kt = 0; kt < 4; ++kt) {
        __syncthreads();
        { v4u t[4];
#pragma unroll
          for (int i = 0; i < 4; ++i) { const int p = F.tid + 512 * i, key = p >> 5, seg = p & 31; t[i] = *(const GAS v4u*)(kvb + D + (size_t)(kt * 64 + key) * (2 * D) + seg * 8); }
#pragma unroll
          for (int i = 0; i < 4; ++i) { const int p = F.tid + 512 * i, key = p >> 5, seg = p & 31; *(LAS v4u*)(vt + key * XV_PITCH + seg * 16) = t[i]; } }
        f32x16 p0 = {}, p1 = {};
        const bf16* krow = kvb + (size_t)(kt * 64) * (2 * D);
#pragma unroll 4
        for (int ds = 0; ds < 16; ++ds) {
            const bf16x8 qf = *(const GAS bf16x8*)(qrow + ds * 16 + hi * 8);
            const bf16x8 k0 = *(const GAS bf16x8*)(krow + (size_t)r32 * (2 * D) + ds * 16 + hi * 8);
            const bf16x8 k1 = *(const GAS bf16x8*)(krow + (size_t)(32 + r32) * (2 * D) + ds * 16 + hi * 8);
            p0 = MFMA32(k0, qf, p0); p1 = MFMA32(k1, qf, p1);
        }
        float mx = -1e30f;
#pragma unroll
        for (int i = 0; i < 16; ++i) { p0[i] *= 0.0625f * LOG2E; p1[i] *= 0.0625f * LOG2E; mx = fmaxf(mx, fmaxf(p0[i], p1[i])); }
        mx = fmaxf(mx, __shfl_xor(mx, 32));
        const float mnew = fmaxf(mrun, mx), sc = __builtin_amdgcn_exp2f(mrun - mnew);
        float ls = 0.f;
#pragma unroll
        for (int i = 0; i < 16; ++i) { p0[i] = __builtin_amdgcn_exp2f(p0[i] - mnew); p1[i] = __builtin_amdgcn_exp2f(p1[i] - mnew); ls += p0[i] + p1[i]; }
        lrun = lrun * sc + ls; mrun = mnew;
#pragma unroll
        for (int d = 0; d < 8; ++d)
#pragma unroll
            for (int i = 0; i < 16; ++i) o[d][i] *= sc;
        LDS_WAIT();
        __syncthreads();
#pragma unroll
        for (int ks = 0; ks < 4; ++ks) {
            const bf16x8 pf = pack8((ks >> 1) ? p1 : p0, ks & 1);
            const int kb = 32 * (ks >> 1) + 16 * (ks & 1);
#pragma unroll
            for (int db = 0; db < 8; ++db) {
                const s16x4 lo = vtr(vb + kb * XV_PITCH + db * 64), hh = vtr(vb + (kb + 8) * XV_PITCH + db * 64);
                const bf16x8 vf = __builtin_shufflevector(lo, hh, 0, 1, 2, 3, 4, 5, 6, 7);
                o[db] = MFMA32(vf, pf, o[db]);
            }
        }
    }
    lrun += __shfl_xor(lrun, 32);
    const float il = 1.0f / lrun;
    bf16* rowp = F.OM + (tok0 + r32) * D + hm * HDM + 4 * hi;
#pragma unroll
    for (int db = 0; db < 8; ++db)
#pragma unroll
        for (int g = 0; g < 4; ++g) { v2u wv; wv.x = pk2(o[db][4 * g] * il, o[db][4 * g + 1] * il); wv.y = pk2(o[db][4 * g + 2] * il, o[db][4 * g + 3] * il); *(GAS v2u*)(rowp + 32 * db + 8 * g) = wv; }
    __syncthreads();
}

__device__ __forceinline__ void ln_row(const float* yrow, const float* g, const float* bb, int lane, f32x4 (&v)[4]) {
    const GAS f32x4* yr = (const GAS f32x4*)yrow + lane;
    float s = 0.f;
#pragma unroll
    for (int j = 0; j < 4; ++j) { v[j] = yr[64 * j]; s += (v[j].x + v[j].y) + (v[j].z + v[j].w); }
    const float mean = wave_sum(s) * (1.f / D); float s2 = 0.f;
#pragma unroll
    for (int j = 0; j < 4; ++j) { v[j] = v[j] - mean; s2 += (v[j].x * v[j].x + v[j].y * v[j].y) + (v[j].z * v[j].z + v[j].w * v[j].w); }
    const float rstd = 1.f / sqrtf(wave_sum(s2) * (1.f / D) + LN_EPS);
#pragma unroll
    for (int j = 0; j < 4; ++j) { const f32x4 gg = ((const GAS f32x4*)g)[lane + 64 * j], b4 = ((const GAS f32x4*)bb)[lane + 64 * j]; v[j] = v[j] * rstd * gg + b4; }
}
__device__ __forceinline__ void store_row_f32_bf16(float* xf, bf16* xb, const f32x4 (&v)[4], int lane) {
#pragma unroll
    for (int j = 0; j < 4; ++j) { if (xf) ((GAS f32x4*)xf)[lane + 64 * j] = v[j]; v2u w; w.x = pk2(v[j].x, v[j].y); w.y = pk2(v[j].z, v[j].w); ((GAS v2u*)xb)[lane + 64 * j] = w; }
}
__device__ __forceinline__ void p8_router(Frame& F) {
    LAS float* lgp = (LAS float*)(F.lds + RING_OFF);
    LAS int* tk_e = (LAS int*)(F.lds + P8_TK_OFF); LAS float* tk_g = (LAS float*)(F.lds + P8_TK_OFF + 1024); LAS int* tk_p = (LAS int*)(F.lds + P8_TK_OFF + 2048);
    LAS int* hist = (LAS int*)(F.lds + P8_TK_OFF + 3072); LAS int* basee = hist + 32;
    if (F.tid < 32) hist[F.tid] = 0;
    LDS_WAIT(); __syncthreads();
    const int lane = F.lane, w = F.wave, r32 = lane & 31, hi = lane >> 5;
    const float* g = F.ln_g + D, *bb = F.ln_b + D;
    for (int tile = F.vcu; tile < M / 64; tile += F.G) {
        const int row0 = tile * 64;
        for (int rr = 0; rr < 8; ++rr) { const int ra = row0 + w * 8 + rr; f32x4 va[4]; ln_row(F.Y + (size_t)ra * D, g, bb, lane, va); store_row_f32_bf16(F.X2 + (size_t)ra * D, F.X2B + (size_t)ra * D, va, lane); }
        VM_WAIT(); __syncthreads();
        { const int tb = w & 1, kq = w >> 1;
          const float* xrow = F.X2 + (size_t)(row0 + tb * 32 + r32) * D + kq * 256 + hi * 8;
          const bf16* wh = F.WRH + (size_t)r32 * D + kq * 256 + hi * 8; const bf16* wlo = F.WRL + (size_t)r32 * D + kq * 256 + hi * 8;
          f32x16 acc = {};
#pragma unroll 4
          for (int s2 = 0; s2 < 16; ++s2) {
              const f32x4 xa = *(const GAS f32x4*)(xrow + s2 * 16), xb = *(const GAS f32x4*)(xrow + s2 * 16 + 4);
              v4u ph, pl;
              ph.x = pk2(xa.x, xa.y); ph.y = pk2(xa.z, xa.w); ph.z = pk2(xb.x, xb.y); ph.w = pk2(xb.z, xb.w);
              pl.x = pk2(xa.x - bf2f((unsigned short)(ph.x & 0xffffu)), xa.y - bf2f((unsigned short)(ph.x >> 16))); pl.y = pk2(xa.z - bf2f((unsigned short)(ph.y & 0xffffu)), xa.w - bf2f((unsigned short)(ph.y >> 16)));
              pl.z = pk2(xb.x - bf2f((unsigned short)(ph.z & 0xffffu)), xb.y - bf2f((unsigned short)(ph.z >> 16))); pl.w = pk2(xb.z - bf2f((unsigned short)(ph.w & 0xffffu)), xb.w - bf2f((unsigned short)(ph.w >> 16)));
              const bf16x8 xh = __builtin_bit_cast(bf16x8, ph), xl = __builtin_bit_cast(bf16x8, pl);
              const bf16x8 ah = *(const GAS bf16x8*)(wh + s2 * 16), al = *(const GAS bf16x8*)(wlo + s2 * 16);
              acc = MFMA32(ah, xh, acc); acc = MFMA32(al, xh, acc); acc = MFMA32(ah, xl, acc);
          }
#pragma unroll
          for (int i = 0; i < 16; ++i) lgp[(kq * 64 + tb * 32 + r32) * 33 + crow(i, hi)] = acc[i];
        }
        LDS_WAIT(); __syncthreads();
        if (F.tid < 64) {
            const int r = F.tid; float l[32];
#pragma unroll
            for (int e = 0; e < 32; ++e) l[e] = ((lgp[r * 33 + e] + lgp[(64 + r) * 33 + e]) + (lgp[(128 + r) * 33 + e] + lgp[(192 + r) * 33 + e])) + F.b_router[e];
            int idx[4]; float val[4]; unsigned taken = 0u;
#pragma unroll
            for (int k = 0; k < 4; ++k) { float best = -3.0e38f; int bi = 0;
#pragma unroll
                for (int e = 0; e < 32; ++e) { const bool ok = !((taken >> e) & 1u) && (l[e] > best); best = ok ? l[e] : best; bi = ok ? e : bi; }
                idx[k] = bi; val[k] = best; taken |= 1u << bi; }
            float ex[4], sm = 0.f;
#pragma unroll
            for (int k = 0; k < 4; ++k) { ex[k] = __expf(val[k] - val[0]); sm += ex[k]; }
            const float is = 1.0f / sm;
#pragma unroll
            for (int k = 0; k < 4; ++k) { tk_e[r * 4 + k] = idx[k]; tk_g[r * 4 + k] = ex[k] * is; tk_p[r * 4 + k] = __hip_atomic_fetch_add(hist + idx[k], 1, __ATOMIC_RELAXED, __HIP_MEMORY_SCOPE_WORKGROUP); }
        }
        LDS_WAIT(); __syncthreads();
        if (F.tid < 32) { const int h = hist[F.tid]; int bs = 0; if (h > 0) bs = (int)__hip_atomic_fetch_add((unsigned*)(F.ctl + CW_CNT + 64 * F.tid), (unsigned)h, RLX_AGENT); basee[F.tid] = bs; hist[F.tid] = 0; }
        LDS_WAIT(); __syncthreads();
        if (F.tid < 256) { const int r = F.tid >> 2, k = F.tid & 3, e = tk_e[r * 4 + k], pos = basee[e] + tk_p[r * 4 + k];
            if (pos < CAP) { F.LSLOT[e * CAP + pos] = (row0 + r) * 4 + k; F.LGATE[e * CAP + pos] = tk_g[r * 4 + k]; } }
        LDS_WAIT(); __syncthreads();
    }
}
__device__ __forceinline__ int build_group_table(Frame& F) {
    LAS int* tab = (LAS int*)(F.lds + TAB_OFF);
    __syncthreads();
    if (F.tid < 32) { int c = (int)__hip_atomic_load((unsigned*)(F.ctl + CW_CNT + 64 * F.tid), RLX_AGENT); c = c > CAP ? CAP : c; tab[64 + F.tid] = c; }
    LDS_WAIT(); __syncthreads();
    if (F.tid == 0) { int p = 0; for (int e = 0; e < 32; ++e) { tab[e] = p; p += (tab[64 + e] + 255) >> 8; } tab[32] = p; }
    LDS_WAIT(); __syncthreads();
    return __builtin_amdgcn_readfirstlane(tab[32]);
}
__device__ __forceinline__ void p11_combine(Frame& F) {
    const int gw = F.vcu * NWAVES + F.wave, NGW = F.G * NWAVES, lane = F.lane;
    const float* g = F.ln_g + 2 * D, *bb = F.ln_b + 2 * D;
    for (int m = gw; m < M; m += NGW) {
        const GAS f32x4* xr = (const GAS f32x4*)(F.X2 + (size_t)m * D) + lane;
        f32x4 v[4]; float s = 0.f;
#pragma unroll
        for (int j = 0; j < 4; ++j) { f32x4 a = xr[64 * j] * ALPHA;
#pragma unroll
            for (int k = 0; k < 4; ++k) { const v2u y = ((const GAS v2u*)(F.YS + ((size_t)m * 4 + k) * D))[lane + 64 * j];
                a.x += bf2f((unsigned short)(y.x & 0xffffu)); a.y += bf2f((unsigned short)(y.x >> 16)); a.z += bf2f((unsigned short)(y.y & 0xffffu)); a.w += bf2f((unsigned short)(y.y >> 16)); }
            v[j] = a; s += (a.x + a.y) + (a.z + a.w); }
        const float mean = wave_sum(s) * (1.f / D); float s2 = 0.f;
#pragma unroll
        for (int j = 0; j < 4; ++j) { v[j] = v[j] - mean; s2 += (v[j].x * v[j].x + v[j].y * v[j].y) + (v[j].z * v[j].z + v[j].w * v[j].w); }
        const float rstd = 1.f / sqrtf(wave_sum(s2) * (1.f / D) + LN_EPS);
#pragma unroll
        for (int j = 0; j < 4; ++j) { const f32x4 gg = ((const GAS f32x4*)g)[lane + 64 * j], b4 = ((const GAS f32x4*)bb)[lane + 64 * j]; ((GAS f32x4*)(F.out + (size_t)m * D))[lane + 64 * j] = v[j] * rstd * gg + b4; }
    }
}

__device__ __forceinline__ void p1_qkv(Frame& F) {
    pg8::Gemm g{F.XB, F.Win_t, M, NQKV, D, nullptr, D, D}; pg8::StaticOrder S; S.init(M, NQKV, F.G, (int)blockIdx.x);
    pg8::EpiBf16 E{F.QKV, NQKV};
    pg8::gemm_phase<pg8::EpiBf16, pg8::StaticOrder, false, true>(F.lds + RING_OFF, g, S, E);
}
__device__ __forceinline__ void p2_mixer(Frame& F) { for (int u = F.vcu; u < BATCH * (SEQ / CHUNK); u += F.G) mixer_unit(F, u); }
__device__ __forceinline__ void p3_outproj(Frame& F) {
    pg8::Gemm g{F.MIXN, F.Wout_t, M, D, D, nullptr, D, D}; pg8::StaticOrder S; S.init(M, D, F.G, (int)blockIdx.x);
    pg8::EpiResF32 E{F.Y, F.x, D, ALPHA};
    pg8::gemm_phase<pg8::EpiResF32, pg8::StaticOrder, false, false>(F.lds + RING_OFF, g, S, E);
}
__device__ __forceinline__ void p4_ln1_kv(Frame& F) {
    if (F.vcu < 16) {
        pg8::Gemm g{F.MEMB, F.Wkv_t, MEMROWS, 2 * D, D, nullptr, D, D}; pg8::StaticOrder S; S.init(MEMROWS, 2 * D, 16, F.vcu);
        pg8::EpiBf16 E{F.KVM, 2 * D};
        pg8::gemm_phase<pg8::EpiBf16, pg8::StaticOrder, false, false>(F.lds + RING_OFF, g, S, E);
    }
    const int gw = F.vcu * NWAVES + F.wave, NGW = F.G * NWAVES;
    for (int m = gw; m < M; m += NGW) { f32x4 v[4]; ln_row(F.Y + (size_t)m * D, F.ln_g, F.ln_b, F.lane, v); store_row_f32_bf16(F.X1 + (size_t)m * D, F.X1B + (size_t)m * D, v, F.lane); }
}
__device__ __forceinline__ void p5_fold(Frame& F) {
    if (F.vcu < 32) {
        pg8::Gemm g{F.KVM, F.Wq_n, 256, D, 256, nullptr, 2 * D, D}; pg8::MiniOrder S{0, F.vcu};
        pg8::EpiScaleBf16C E{F.WKT, D, 0.0625f * LOG2E};
        pg8::gemm_phase<pg8::EpiScaleBf16C, pg8::MiniOrder, false, false>(F.lds + RING_OFF, g, S, E);
    } else if (F.vcu < 64) {
        pg8::Gemm g{F.Wo_t, F.KVM, D, 256, 256, nullptr, D, 2 * D}; pg8::MiniOrder S{1, F.vcu - 32};
        pg8::EpiScaleBf16C E{F.VWT, D, 1.0f};
        pg8::gemm_phase<pg8::EpiScaleBf16C, pg8::MiniOrder, false, false>(F.lds + RING_OFF, g, S, E);
    }
}
__device__ __forceinline__ void p6_scores(Frame& F) {
    pg8::Gemm g{F.X1B, F.WKT, M, D, D, nullptr, D, D}; pg8::BatchOrder S; S.init(M, D, F.G, (int)blockIdx.x); S.bbatch = (size_t)D * D * 2;
    pg8::EpiSoftmax E{F.PB, D, (LAS f32x2*)(F.lds + XCH_OFF)};
    pg8::gemm_phase<pg8::EpiSoftmax, pg8::BatchOrder, false, true>(F.lds + RING_OFF, g, S, E);
}
__device__ __forceinline__ void p7_pv(Frame& F) {
    pg8::Gemm g{F.PB, F.VWT, M, D, D, nullptr, D, D}; pg8::BatchOrder S; S.init(M, D, F.G, (int)blockIdx.x); S.bbatch = (size_t)D * D * 2;
    pg8::EpiResF32 E{F.Y, F.X1, D, ALPHA};
    pg8::gemm_phase<pg8::EpiResF32, pg8::BatchOrder, false, false>(F.lds + RING_OFF, g, S, E);
}
__device__ __forceinline__ void p9_gateup(Frame& F) {
    const int ntile = build_group_table(F);
    pg8::Gemm g{F.X2B, F.Wgu_t, 0, 2 * DFF, D, F.LSLOT, D, D};
    pg8::GroupOrder S{(const LAS int*)(F.lds + TAB_OFF), 2 * DFF / 256, ntile * (2 * DFF / 256), F.G, F.vcu, (size_t)2 * DFF * D * 2};
    pg8::EpiSwiglu E{F.H, F.b_gu};
    pg8::gemm_phase<pg8::EpiSwiglu, pg8::GroupOrder, true, true>(F.lds + RING_OFF, g, S, E);
}
__device__ __forceinline__ void p10_down(Frame& F) {
    const int ntile = build_group_table(F);
    pg8::Gemm g{F.H, F.Wd_t, 0, D, DFF, nullptr, DFF, DFF};
    pg8::GroupOrder S{(const LAS int*)(F.lds + TAB_OFF), D / 256, ntile * (D / 256), F.G, F.vcu, (size_t)D * DFF * 2};
    pg8::EpiDown E{F.YS, F.b_down, F.LSLOT, F.LGATE};
    pg8::gemm_phase<pg8::EpiDown, pg8::GroupOrder, false, true>(F.lds + RING_OFF, g, S, E);
}

struct Args { const float* in[18]; float* out; unsigned char* ws; int ph_lo, ph_hi; };
__global__ void __launch_bounds__(NWAVES * 64, 2) trunk_fwd(Args args) {
    extern __shared__ __attribute__((aligned(16))) unsigned char lds[];
    Frame F;
    F.lds = (LAS unsigned char*)lds;
    F.MISC = (volatile LAS unsigned*)(F.lds + MISC_OFF);
    F.tid = threadIdx.x; F.lane = F.tid & 63; F.wave = __builtin_amdgcn_readfirstlane(F.tid >> 6);
    F.G = gridDim.x; { const int bx = blockIdx.x; F.vcu = (F.G % 8 == 0) ? (bx % 8) * (F.G / 8) + bx / 8 : bx; }
    unsigned char* ws = args.ws;
    F.ctl = (gu32*)(ws + WS_CTL);
    F.x = args.in[0]; F.mem = args.in[1]; F.w_in = args.in[2]; F.rel_bias = args.in[3]; F.g_a = args.in[4]; F.g_b = args.in[5]; F.w_out = args.in[6]; F.w_q = args.in[7]; F.w_kv = args.in[8];
    F.w_o = args.in[9]; F.w_router = args.in[10]; F.b_router = args.in[11]; F.w_gu = args.in[12]; F.b_gu = args.in[13]; F.w_down = args.in[14]; F.b_down = args.in[15]; F.ln_g = args.in[16]; F.ln_b = args.in[17];
    F.out = args.out;
    F.Win_t = (bf16*)(ws + WS_WIN); F.Wout_t = (bf16*)(ws + WS_WOUT); F.Wq_n = (bf16*)(ws + WS_WQ); F.WKT = (bf16*)(ws + WS_WKT); F.VWT = (bf16*)(ws + WS_VWT); F.PB = (bf16*)(ws + WS_QM); F.Wkv_t = (bf16*)(ws + WS_WKV); F.Wo_t = (bf16*)(ws + WS_WO); F.Wgu_t = (bf16*)(ws + WS_WGU); F.Wd_t = (bf16*)(ws + WS_WD); F.WRH = (bf16*)(ws + WS_WRH); F.WRL = (bf16*)(ws + WS_WRL);
    F.XB = (bf16*)(ws + WS_XB); F.MEMB = (bf16*)(ws + WS_MEMB); F.KVM = (bf16*)(ws + WS_KVM); F.QKV = (bf16*)(ws + WS_QKV); F.MIXN = (bf16*)(ws + WS_MIXN); F.X1B = (bf16*)(ws + WS_X1B);
    F.QM = (bf16*)(ws + WS_QM); F.OM = (bf16*)(ws + WS_OM); F.X2B = (bf16*)(ws + WS_X2B); F.H = (bf16*)(ws + WS_H); F.YS = (bf16*)(ws + WS_YS);
    F.Y = (float*)(ws + WS_Y); F.X1 = (float*)(ws + WS_X1); F.X2 = (float*)(ws + WS_X2); F.LGATE = (float*)(ws + WS_LGATE); F.LSLOT = (int*)(ws + WS_LSLOT);
    for (int u = F.tid; u < (LDS_BYTES - LDSCTL_OFF) / 4; u += NWAVES * 64) ((LAS unsigned*)(F.lds + LDSCTL_OFF))[u] = 0u;
    __syncthreads();
    XcdBarrier bar; bar.bar = (unsigned*)(F.ctl + CW_BAR); bar.x = 0; bar.st = nullptr;
    if (N_LAUNCHES != PER_PHASE) bar = xcd_barrier_post((unsigned*)(F.ctl + CW_BAR), F.MISC + 8);
#define GRID_BAR() do { if (N_LAUNCHES != PER_PHASE) xcd_barrier(bar); } while (0)
    const int lo = args.ph_lo, hi = args.ph_hi;
#ifndef PH_MASK
#define PH_MASK 0xFFF
#endif
#define IN(k) (lo <= (k) && (k) < hi && ((PH_MASK >> (k)) & 1))
#define BOTH(k) (IN(k) && IN((k) + 1))

#ifndef REP_MASK
#define REP_MASK 0
#endif
#define PHASE(k, fn) if (IN(k)) { fn(F); if ((REP_MASK >> (k)) & 1) { GRID_BAR(); fn(F); } if (BOTH(k)) GRID_BAR(); }
    PHASE(0, p0_prologue)
    PHASE(1, p1_qkv)
    PHASE(2, p2_mixer)
    PHASE(3, p3_outproj)
    PHASE(4, p4_ln1_kv)
    PHASE(5, p5_fold)
    PHASE(6, p6_scores)
    PHASE(7, p7_pv)
    PHASE(8, p8_router)
    PHASE(9, p9_gateup)
    PHASE(10, p10_down)
    PHASE(11, p11_combine)
#undef IN
#undef BOTH
#undef PHASE
}

extern "C" void kernel_launch(void* const* d_in, const int* in_sizes, int n_in, void* d_out, int out_size, void* d_ws, size_t ws_size, hipStream_t stream) {
    static int grid = 0;
    if (grid == 0) {
        if (n_in != 18 || in_sizes[0] != M * D || out_size != M * D || ws_size < WS_END) { fprintf(stderr, "kernel_launch: unexpected shapes (n_in %d, in0 %d, out %d, ws %zu); nothing launched\n", n_in, n_in > 0 ? in_sizes[0] : -1, out_size, ws_size); grid = -1; return; }
        int dev = 0, cus = 0, per_cu = 0;
        if (hipGetDevice(&dev) != hipSuccess || hipDeviceGetAttribute(&cus, hipDeviceAttributeMultiprocessorCount, dev) != hipSuccess) { grid = -1; return; }
        if (hipFuncSetAttribute((const void*)trunk_fwd, hipFuncAttributeMaxDynamicSharedMemorySize, LDS_BYTES) != hipSuccess) { fprintf(stderr, "kernel_launch: hipFuncSetAttribute failed\n"); grid = -1; return; }
        if (hipOccupancyMaxActiveBlocksPerMultiprocessor(&per_cu, (const void*)trunk_fwd, NWAVES * 64, LDS_BYTES) != hipSuccess || per_cu < 1)
            fprintf(stderr, "kernel_launch: note: occupancy query reports %d workgroups per CU\n", per_cu);
        (void)hipGetLastError();
        grid = cus;
    }
    if (grid < 0) return;
    if (hipMemsetAsync((char*)d_ws + WS_CTL, 0, CTL_ZERO_BYTES, stream) != hipSuccess) return;
    Args a{};
    for (int i = 0; i < 18; ++i) a.in[i] = (const float*)d_in[i];
    a.out = (float*)d_out; a.ws = (unsigned char*)d_ws;
    if (N_LAUNCHES == 1) { a.ph_lo = 0; a.ph_hi = PER_PHASE; hipLaunchKernelGGL(trunk_fwd, dim3(grid), dim3(NWAVES * 64), LDS_BYTES, stream, a); }
    else for (int li = 0; li < PER_PHASE; ++li) { a.ph_lo = li; a.ph_hi = li + 1; hipLaunchKernelGGL(trunk_fwd, dim3(grid), dim3(NWAVES * 64), LDS_BYTES, stream, a); }
}
```
